# Optimizing an MI355X kernel written in HIP

```python
import math
import jax, jax.numpy as jnp
from jax import lax
import numpy as np


D_MODEL = 2048
BATCH = 4
SEQ = 2048
DEPTH = 1

HEAD_DIM = 128
N_NSA_HEADS = D_MODEL // (2 * HEAD_DIM)
N_NSA_KV = max(1, N_NSA_HEADS // 4)
N_FOX_HEADS = D_MODEL // (2 * HEAD_DIM)
D_NSA = N_NSA_HEADS * HEAD_DIM
D_FOX = N_FOX_HEADS * HEAD_DIM
D_MIX = D_NSA + D_FOX
D_KV = N_NSA_KV * HEAD_DIM
IN_SIZES = (D_NSA, D_KV, D_KV, D_KV, D_KV, D_KV, D_KV, 3 * N_NSA_HEADS, D_FOX, D_FOX, D_FOX, N_FOX_HEADS)
D_IN = sum(IN_SIZES)
IN_SPLITS = tuple(int(v) for v in np.cumsum(IN_SIZES)[:-1])

CMP_LEN = 32
CMP_STRIDE = 16
CMP_HIDDEN = 256
SLC_BLOCK = 64
SLC_TOPK = 16
WINDOW = 512
Q_BLOCK = 128
SLC_Q_BLOCK = 64
N_BUCKETS = 32
MAX_DISTANCE = 128
N_EXPERTS = 32
TOP_K = 4
EXPERT_FF = D_MODEL
SWIGLU_ALPHA = 1.702
SWIGLU_LIMIT = 7.0
MOE_BLOCK = 256
SCALE = HEAD_DIM ** -0.5
NEG_INF = -1e30
FORCED_SCORE = 1e6
EPS = 1e-6

kernel_name = "hymba_nsa_fox_moe_block"


def rms_norm(x, g):
    xf = x.astype(jnp.float32)
    y = xf * lax.rsqrt(jnp.mean(xf * xf, axis=-1, keepdims=True) + EPS)
    return (y * g.astype(jnp.float32)).astype(x.dtype)


def masked_softmax(logits, mask):
    logits = jnp.where(mask, logits.astype(jnp.float32), NEG_INF)
    return jax.nn.softmax(logits, axis=-1) * mask


def t5_bucket(dist):
    n = jnp.maximum(dist, 0)
    max_exact = N_BUCKETS // 2
    nf = jnp.maximum(n, 1).astype(jnp.float32)
    large = max_exact + (jnp.log(nf / max_exact) / math.log(MAX_DISTANCE / max_exact)
                         * (N_BUCKETS - max_exact)).astype(jnp.int32)
    large = jnp.minimum(large, N_BUCKETS - 1)
    return jnp.where(n < max_exact, n, large)


def nsa_compress(k, pos, w1, w2):
    B, S, G, dh = k.shape
    n_cmp = (S - CMP_LEN) // CMP_STRIDE + 1
    idx = jnp.arange(n_cmp)[:, None] * CMP_STRIDE + jnp.arange(CMP_LEN)[None, :]
    blocks = k[:, idx] + pos[:, None, :]
    flat = blocks.transpose(0, 1, 3, 2, 4).reshape(B, n_cmp, G, CMP_LEN * dh)
    return jax.nn.gelu(flat @ w1) @ w2


def nsa_compressed_branch(qg, kc, vc, rel_bias):
    B, S, G, R, _ = qg.shape
    n_cmp = kc.shape[1]
    logits = jnp.einsum('bsgrd,bngd->bgrsn', qg, kc).astype(jnp.float32) * SCALE
    dist = jnp.arange(S)[:, None] - (jnp.arange(n_cmp) * CMP_STRIDE + CMP_LEN - 1)[None, :]
    bias = rel_bias[t5_bucket(dist)].reshape(S, n_cmp, G, R).transpose(2, 3, 0, 1)
    p = masked_softmax(logits + bias, dist >= 0)
    o = jnp.einsum('bgrsn,bngd->bsgrd', p.astype(vc.dtype), vc)
    return o, p


def nsa_select_blocks(p_cmp, S):
    n_cmp = p_cmp.shape[-1]
    n_slc = S // SLC_BLOCK
    k_sel = min(SLC_TOPK, n_slc)
    cmp_start = jnp.arange(n_cmp) * CMP_STRIDE
    slc_start = jnp.arange(n_slc) * SLC_BLOCK
    overlap = ((cmp_start[:, None] < slc_start[None, :] + SLC_BLOCK)
               & (cmp_start[:, None] + CMP_LEN > slc_start[None, :])).astype(jnp.float32)
    imp = jnp.einsum('bgrsn,nj->bgsj', p_cmp, overlap)
    t = jnp.arange(S)[:, None]
    j = jnp.arange(n_slc)[None, :]
    cur = t // SLC_BLOCK
    forced = (j == 0) | (j == cur) | (j == cur - 1)
    valid = j <= cur
    imp = jnp.where(forced, FORCED_SCORE, jnp.where(valid, imp, -FORCED_SCORE))
    _, sel = lax.top_k(imp, k_sel)
    return sel


def nsa_selected_branch(qg, k, v, sel, rel_bias):
    B, S, G, R, dh = qg.shape
    n_tok = sel.shape[-1] * SLC_BLOCK
    k_t = k.transpose(0, 2, 1, 3)
    v_t = v.transpose(0, 2, 1, 3)
    table_gr = rel_bias.reshape(N_BUCKETS, G, R).transpose(1, 0, 2)
    gather = jax.vmap(jax.vmap(lambda src, idx: src[idx]))
    g_idx = jnp.arange(G)[None, :, None, None]

    def chunk(ci):
        q0 = ci * SLC_Q_BLOCK
        qc = lax.dynamic_slice_in_dim(qg, q0, SLC_Q_BLOCK, axis=1)
        sc = lax.dynamic_slice_in_dim(sel, q0, SLC_Q_BLOCK, axis=2)
        tok = (sc[..., None] * SLC_BLOCK + jnp.arange(SLC_BLOCK)).reshape(B, G, SLC_Q_BLOCK * n_tok)
        kk = gather(k_t, tok).reshape(B, G, SLC_Q_BLOCK, n_tok, dh)
        vv = gather(v_t, tok).reshape(B, G, SLC_Q_BLOCK, n_tok, dh)
        logits = jnp.einsum('bqgrd,bgqkd->bgrqk', qc, kk).astype(jnp.float32) * SCALE
        dist = (q0 + jnp.arange(SLC_Q_BLOCK))[:, None] - tok.reshape(B, G, SLC_Q_BLOCK, n_tok)
        bias = table_gr[g_idx, t5_bucket(dist)]
        p = masked_softmax(logits + jnp.moveaxis(bias, -1, 2), (dist >= 0)[:, :, None])
        return jnp.einsum('bgrqk,bgqkd->bqgrd', p.astype(vv.dtype), vv)

    out = lax.map(chunk, jnp.arange(S // SLC_Q_BLOCK))
    return jnp.moveaxis(out, 0, 1).reshape(B, S, G * R, dh)


def nsa_window_branch(qg, kw, vw, rel_bias):
    B, S, G, R, dh = qg.shape
    n_kw = WINDOW + Q_BLOCK
    kp = jnp.pad(kw, ((0, 0), (WINDOW, 0), (0, 0), (0, 0)))
    vp = jnp.pad(vw, ((0, 0), (WINDOW, 0), (0, 0), (0, 0)))
    rel = jnp.arange(Q_BLOCK)[:, None] + WINDOW - jnp.arange(n_kw)[None, :]
    bias = rel_bias[t5_bucket(rel)].reshape(Q_BLOCK, n_kw, G, R).transpose(2, 3, 0, 1)
    band = (rel >= 0) & (rel < WINDOW)

    def chunk(ci):
        q0 = ci * Q_BLOCK
        qc = lax.dynamic_slice_in_dim(qg, q0, Q_BLOCK, axis=1)
        kc = lax.dynamic_slice_in_dim(kp, q0, n_kw, axis=1)
        vc = lax.dynamic_slice_in_dim(vp, q0, n_kw, axis=1)
        logits = jnp.einsum('bqgrd,bkgd->bgrqk', qc, kc).astype(jnp.float32) * SCALE + bias
        mask = band & (q0 - WINDOW + jnp.arange(n_kw) >= 0)[None, :]
        p = masked_softmax(logits, mask)
        return jnp.einsum('bgrqk,bkgd->bqgrd', p.astype(vc.dtype), vc)

    out = lax.map(chunk, jnp.arange(S // Q_BLOCK))
    return jnp.moveaxis(out, 0, 1).reshape(B, S, G * R, dh)


def forgetting_attention(q, k, v, f_logit):
    B, S, H, dh = q.shape
    cum = jnp.cumsum(jax.nn.log_sigmoid(f_logit.astype(jnp.float32)), axis=1).transpose(0, 2, 1)
    kpos = jnp.arange(S)

    def chunk(ci):
        q0 = ci * Q_BLOCK
        qc = lax.dynamic_slice_in_dim(q, q0, Q_BLOCK, axis=1)
        cq = lax.dynamic_slice_in_dim(cum, q0, Q_BLOCK, axis=2)
        logits = (jnp.einsum('bqhd,bkhd->bhqk', qc, k).astype(jnp.float32) * SCALE
                  + cq[..., None] - cum[:, :, None, :])
        mask = (q0 + jnp.arange(Q_BLOCK))[:, None] >= kpos[None, :]
        p = masked_softmax(logits, mask)
        return jnp.einsum('bhqk,bkhd->bqhd', p.astype(v.dtype), v)

    out = lax.map(chunk, jnp.arange(S // Q_BLOCK))
    return jnp.moveaxis(out, 0, 1).reshape(B, S, H, dh)


def token_mixers(h, rel_bias, w_in, b_nsa_gate, nsa_q_norm, nsa_k_norm, cmp_pos_k, cmp_pos_v,
                 cmp_k_w1, cmp_k_w2, cmp_v_w1, cmp_v_w2, fox_q_norm, fox_k_norm, fox_forget_bias, out_norm):
    B, S, _ = h.shape
    G, R = N_NSA_KV, N_NSA_HEADS // N_NSA_KV
    proj = h @ w_in
    q_n, k_c, v_c, k_s, v_s, k_w, v_w, g_n, q_f, k_f, v_f, f_f = jnp.split(proj, IN_SPLITS, axis=-1)
    hd = lambda t, n: t.reshape(B, S, n, HEAD_DIM)
    qg = rms_norm(hd(q_n, N_NSA_HEADS), nsa_q_norm).reshape(B, S, G, R, HEAD_DIM)
    kc = rms_norm(nsa_compress(hd(k_c, G), cmp_pos_k, cmp_k_w1, cmp_k_w2), nsa_k_norm[0])
    vc = nsa_compress(hd(v_c, G), cmp_pos_v, cmp_v_w1, cmp_v_w2)
    o_cmp, p_cmp = nsa_compressed_branch(qg, kc, vc, rel_bias)
    o_cmp = o_cmp.reshape(B, S, N_NSA_HEADS, HEAD_DIM)
    sel = nsa_select_blocks(p_cmp, S)
    o_slc = nsa_selected_branch(qg, rms_norm(hd(k_s, G), nsa_k_norm[1]), hd(v_s, G), sel, rel_bias)
    o_win = nsa_window_branch(qg, rms_norm(hd(k_w, G), nsa_k_norm[2]), hd(v_w, G), rel_bias)
    gates = jax.nn.sigmoid(g_n + b_nsa_gate).reshape(B, S, 3, N_NSA_HEADS, 1)
    o_nsa = gates[:, :, 0] * o_cmp + gates[:, :, 1] * o_slc + gates[:, :, 2] * o_win
    o_fox = forgetting_attention(rms_norm(hd(q_f, N_FOX_HEADS), fox_q_norm),
                                 rms_norm(hd(k_f, N_FOX_HEADS), fox_k_norm),
                                 hd(v_f, N_FOX_HEADS), f_f + fox_forget_bias)
    o_nsa = rms_norm(o_nsa.reshape(B, S, D_NSA), out_norm[:D_NSA])
    o_fox = rms_norm(o_fox.reshape(B, S, D_FOX), out_norm[D_NSA:])
    return jnp.concatenate([o_nsa, o_fox], axis=-1)


def moe_ffn(h, router_w, router_b, w_up, b_up, w_down, b_down):
    B, S, D = h.shape
    T = B * S
    TK = T * TOP_K
    xs = h.reshape(T, D)
    logits = (xs @ router_w + router_b).astype(jnp.float32)
    top_v, top_i = lax.top_k(logits, TOP_K)
    gate = jax.nn.softmax(top_v, axis=-1).astype(xs.dtype)
    flat_e = top_i.reshape(-1)
    flat_tok = jnp.arange(TK) // TOP_K
    flat_w = gate.reshape(-1)
    order = jnp.argsort(flat_e)
    se, stok, sw = flat_e[order], flat_tok[order], flat_w[order]
    counts = jnp.zeros((N_EXPERTS,), jnp.int32).at[flat_e].add(1)
    pcounts = (counts + MOE_BLOCK - 1) // MOE_BLOCK * MOE_BLOCK
    off = jnp.cumsum(counts) - counts
    pend = jnp.cumsum(pcounts)
    poff = pend - pcounts
    dest = poff[se] + (jnp.arange(TK) - off[se])
    n_blocks = -(-TK // MOE_BLOCK) + N_EXPERTS
    n_rows = n_blocks * MOE_BLOCK
    row_tok = jnp.full((n_rows,), T, jnp.int32).at[dest].set(stok)
    row_w = jnp.zeros((n_rows,), xs.dtype).at[dest].set(sw)
    block_e = jnp.minimum(jnp.sum((jnp.arange(n_blocks) * MOE_BLOCK)[:, None] >= pend[None, :], axis=1),
                          N_EXPERTS - 1)
    x_pad = jnp.concatenate([xs, jnp.zeros((1, D), xs.dtype)], axis=0)

    def expert_block(args):
        tok, w, e = args
        hu = x_pad[tok] @ w_up[e] + b_up[e]
        glu = jnp.minimum(hu[:, :EXPERT_FF], SWIGLU_LIMIT)
        lin = jnp.clip(hu[:, EXPERT_FF:], -SWIGLU_LIMIT, SWIGLU_LIMIT)
        act = glu * jax.nn.sigmoid(SWIGLU_ALPHA * glu) * (lin + 1)
        return (act @ w_down[e] + b_down[e]) * w[:, None]

    ys = lax.map(expert_block, (row_tok.reshape(n_blocks, MOE_BLOCK), row_w.reshape(n_blocks, MOE_BLOCK), block_e))
    out = jnp.zeros((T + 1, D), ys.dtype).at[row_tok].add(ys.reshape(n_rows, D))[:T]
    return out.reshape(B, S, D)


def hybrid_layer(x, c, rel_bias, mod_w, mod_b, norm_attn, norm_moe, w_in, b_nsa_gate, nsa_q_norm, nsa_k_norm,
                 cmp_pos_k, cmp_pos_v, cmp_k_w1, cmp_k_w2, cmp_v_w1, cmp_v_w2, fox_q_norm, fox_k_norm,
                 fox_forget_bias, out_norm, w_out, router_w, router_b, exp_w_up, exp_b_up, exp_w_down, exp_b_down):
    mod = jax.nn.silu(c) @ mod_w + mod_b
    shift_a, scale_a, gate_a, shift_m, scale_m, gate_m = jnp.split(mod[:, None, :], 6, axis=-1)
    h = rms_norm(x, norm_attn) * (1 + scale_a) + shift_a
    mix = token_mixers(h, rel_bias, w_in, b_nsa_gate, nsa_q_norm, nsa_k_norm, cmp_pos_k, cmp_pos_v,
                       cmp_k_w1, cmp_k_w2, cmp_v_w1, cmp_v_w2, fox_q_norm, fox_k_norm, fox_forget_bias, out_norm)
    x = x + gate_a * (mix @ w_out)
    h = rms_norm(x, norm_moe) * (1 + scale_m) + shift_m
    x = x + gate_m * moe_ffn(h, router_w, router_b, exp_w_up, exp_b_up, exp_w_down, exp_b_down)
    return x


def setup_inputs(seed: int = 0) -> dict:
    key = jax.random.key(seed)
    ks = jax.random.split(key, 32)
    D, L, E, F = D_MODEL, DEPTH, N_EXPERTS, EXPERT_FF

    def nrm(k, shape, s):
        return jax.random.normal(k, shape, jnp.float32) * s

    return {
        "x": nrm(ks[0], (BATCH, SEQ, D), 1.0),
        "c": nrm(ks[1], (BATCH, D), 1.0),
        "rel_bias": nrm(ks[2], (N_BUCKETS, N_NSA_HEADS), 0.5),
        "mod_w": nrm(ks[3], (L, D, 6 * D), D ** -0.5),
        "mod_b": nrm(ks[4], (L, 6 * D), 0.02),
        "norm_attn": 1.0 + nrm(ks[5], (L, D), 0.02),
        "norm_moe": 1.0 + nrm(ks[6], (L, D), 0.02),
        "w_in": nrm(ks[7], (L, D, D_IN), D ** -0.5),
        "b_nsa_gate": nrm(ks[8], (L, 3 * N_NSA_HEADS), 0.1),
        "nsa_q_norm": 1.0 + nrm(ks[9], (L, HEAD_DIM), 0.02),
        "nsa_k_norm": 1.0 + nrm(ks[10], (L, 3, HEAD_DIM), 0.02),
        "cmp_pos_k": nrm(ks[11], (L, CMP_LEN, HEAD_DIM), 0.1),
        "cmp_pos_v": nrm(ks[12], (L, CMP_LEN, HEAD_DIM), 0.1),
        "cmp_k_w1": nrm(ks[13], (L, CMP_LEN * HEAD_DIM, CMP_HIDDEN), (CMP_LEN * HEAD_DIM) ** -0.5),
        "cmp_k_w2": nrm(ks[14], (L, CMP_HIDDEN, HEAD_DIM), CMP_HIDDEN ** -0.5),
        "cmp_v_w1": nrm(ks[15], (L, CMP_LEN * HEAD_DIM, CMP_HIDDEN), (CMP_LEN * HEAD_DIM) ** -0.5),
        "cmp_v_w2": nrm(ks[16], (L, CMP_HIDDEN, HEAD_DIM), CMP_HIDDEN ** -0.5),
        "fox_q_norm": 1.0 + nrm(ks[17], (L, HEAD_DIM), 0.02),
        "fox_k_norm": 1.0 + nrm(ks[18], (L, HEAD_DIM), 0.02),
        "fox_forget_bias": 2.0 + nrm(ks[19], (L, N_FOX_HEADS), 0.5),
        "out_norm": 1.0 + nrm(ks[20], (L, D_MIX), 0.02),
        "w_out": nrm(ks[21], (L, D_MIX, D), D_MIX ** -0.5),
        "router_w": nrm(ks[22], (L, D, E), D ** -0.5),
        "router_b": nrm(ks[23], (L, E), 0.01),
        "exp_w_up": nrm(ks[24], (L, E, D, 2 * F), D ** -0.5),
        "exp_b_up": nrm(ks[25], (L, E, 2 * F), 0.01),
        "exp_w_down": nrm(ks[26], (L, E, F, D), F ** -0.5),
        "exp_b_down": nrm(ks[27], (L, E, D), 0.01),
    }


def reference(x, c, rel_bias, mod_w, mod_b, norm_attn, norm_moe, w_in, b_nsa_gate, nsa_q_norm, nsa_k_norm,
              cmp_pos_k, cmp_pos_v, cmp_k_w1, cmp_k_w2, cmp_v_w1, cmp_v_w2, fox_q_norm, fox_k_norm,
              fox_forget_bias, out_norm, w_out, router_w, router_b, exp_w_up, exp_b_up, exp_w_down, exp_b_down):
    for l in range(DEPTH):
        x = hybrid_layer(x, c, rel_bias, mod_w[l], mod_b[l], norm_attn[l], norm_moe[l], w_in[l], b_nsa_gate[l],
                         nsa_q_norm[l], nsa_k_norm[l], cmp_pos_k[l], cmp_pos_v[l], cmp_k_w1[l], cmp_k_w2[l],
                         cmp_v_w1[l], cmp_v_w2[l], fox_q_norm[l], fox_k_norm[l], fox_forget_bias[l], out_norm[l],
                         w_out[l], router_w[l], router_b[l], exp_w_up[l], exp_b_up[l], exp_w_down[l], exp_b_down[l])
    return x
```

```cpp
#include <hip/hip_runtime.h>
#include <stdint.h>

namespace {
constexpr int D = 2048, NB = 4, S = 2048, T = NB * S;
constexpr int DH = 128, G = 2, R = 4;
constexpr int D_IN = 5664;
constexpr int OFF_QN = 0, OFF_KC = 1024, OFF_VC = 1280, OFF_KS = 1536, OFF_VS = 1792, OFF_KW = 2048, OFF_VW = 2304,
              OFF_GN = 2560, OFF_QF = 2584, OFF_KF = 3608, OFF_VF = 4632, OFF_FF = 5656;
constexpr int NCMP = 127, CMPH = 256, CMPR = NB * NCMP * G;
constexpr int NE = 32, F = 2048, TK = T * 4;
constexpr float SCALE = 0.08838834764831845f;
constexpr float EPS = 1e-6f;
constexpr int NTHR = 512;

__device__ const unsigned char BUCKET[128] = {
 0, 1, 2, 3, 4, 5, 6, 7, 8, 9, 10, 11, 12, 13, 14, 15, 16, 16, 16, 17, 17, 18, 18, 18, 19, 19, 19, 20, 20, 20, 20, 21,
 21, 21, 21, 22, 22, 22, 22, 22, 23, 23, 23, 23, 23, 23, 24, 24, 24, 24, 24, 24, 25, 25, 25, 25, 25, 25, 25, 26, 26, 26, 26, 26,
 26, 26, 26, 27, 27, 27, 27, 27, 27, 27, 27, 27, 27, 28, 28, 28, 28, 28, 28, 28, 28, 28, 28, 29, 29, 29, 29, 29, 29, 29, 29, 29,
 29, 29, 29, 30, 30, 30, 30, 30, 30, 30, 30, 30, 30, 30, 30, 30, 30, 31, 31, 31, 31, 31, 31, 31, 31, 31, 31, 31, 31, 31, 31, 31};
__device__ __forceinline__ int t5bucket(int d) { return BUCKET[d > 127 ? 127 : d]; }

struct P {
    const float *x, *c, *rel_bias, *mod_w, *mod_b, *norm_attn, *norm_moe, *w_in, *b_nsa_gate, *nsa_q_norm, *nsa_k_norm,
        *cmp_pos_k, *cmp_pos_v, *cmp_k_w1, *cmp_k_w2, *cmp_v_w1, *cmp_v_w2, *fox_q_norm, *fox_k_norm, *fox_forget_bias,
        *out_norm, *w_out, *router_w, *router_b, *w_up, *b_up, *w_down, *b_down;
    float* out;
    float *mod, *h, *proj, *cum, *flat, *hid, *cmp, *ocmp, *oslc, *owin, *ofox, *mix, *x1, *h2, *topw, *hu, *act, *y;
    unsigned* sel; int* topi; int* cnt; int* list;
};

__device__ __forceinline__ float wave_sum(float v) {
#pragma unroll
    for (int o = 32; o > 0; o >>= 1) v += __shfl_xor(v, o);
    return v;
}
__device__ __forceinline__ float wave_max(float v) {
#pragma unroll
    for (int o = 32; o > 0; o >>= 1) v = fmaxf(v, __shfl_xor(v, o));
    return v;
}
__device__ __forceinline__ float block_sum(float v, float* red) {
    v = wave_sum(v);
    const int w = threadIdx.x >> 6;
    __syncthreads();
    if ((threadIdx.x & 63) == 0) red[w] = v;
    __syncthreads();
    float s = 0.f;
    for (int i = 0; i < (int)(blockDim.x >> 6); ++i) s += red[i];
    return s;
}

__device__ void ph_mod(const P& p, float* lds) {
    const int tid = threadIdx.x, tx = tid & 15, ty = tid >> 4;
    for (int u = blockIdx.x; u < 6 * D / 64; u += gridDim.x) {
        const int n0 = u * 64 + tx * 4;
        float acc[4][4] = {};
        for (int k = ty * 64; k < ty * 64 + 64; ++k) {
            const float4 w = *(const float4*)(p.mod_w + (size_t)k * (6 * D) + n0);
#pragma unroll
            for (int b = 0; b < 4; ++b) {
                const float cv = p.c[b * D + k];
                const float sv = cv / (1.f + __expf(-cv));
                acc[b][0] += sv * w.x; acc[b][1] += sv * w.y; acc[b][2] += sv * w.z; acc[b][3] += sv * w.w;
            }
        }
        __syncthreads();
#pragma unroll
        for (int b = 0; b < 4; ++b)
#pragma unroll
            for (int j = 0; j < 4; ++j) lds[(ty * 4 + b) * 64 + tx * 4 + j] = acc[b][j];
        __syncthreads();
        if (tid < 256) {
            const int b = tid >> 6, n = tid & 63;
            float s = 0.f;
            for (int i = 0; i < 32; ++i) s += lds[(i * 4 + b) * 64 + n];
            p.mod[b * 6 * D + u * 64 + n] = s + p.mod_b[u * 64 + n];
        }
    }
}

__device__ void ph_rmsmod(const float* xin, const float* gw, const float* mod, int shift_chunk, int scale_chunk, float* hout, float* lds) {
    const int tid = threadIdx.x;
    for (int t = blockIdx.x; t < T; t += gridDim.x) {
        const int b = t / S;
        const float4 v = *(const float4*)(xin + (size_t)t * D + tid * 4);
        float ss = v.x * v.x + v.y * v.y + v.z * v.z + v.w * v.w;
        ss = block_sum(ss, lds);
        const float rs = rsqrtf(ss / D + EPS);
        const float4 g = *(const float4*)(gw + tid * 4);
        const float4 sc = *(const float4*)(mod + (size_t)b * 6 * D + scale_chunk * D + tid * 4);
        const float4 sh = *(const float4*)(mod + (size_t)b * 6 * D + shift_chunk * D + tid * 4);
        float4 o;
        o.x = v.x * rs * g.x * (1.f + sc.x) + sh.x; o.y = v.y * rs * g.y * (1.f + sc.y) + sh.y;
        o.z = v.z * rs * g.z * (1.f + sc.z) + sh.z; o.w = v.w * rs * g.w * (1.f + sc.w) + sh.w;
        *(float4*)(hout + (size_t)t * D + tid * 4) = o;
    }
}

template <class ARow, class Epi>
__device__ void gemm_tile_f32(ARow arow, const float* Bm, int ldb, int K, int N, int m0, int n0, int Mvalid, Epi epi, float* lds) {
    float (*As)[132] = (float (*)[132])lds;
    float (*Bs)[68] = (float (*)[68])(lds + 16 * 132);
    const int tid = threadIdx.x, tx = tid & 15, ty = tid >> 4;
    float acc[4][4] = {};
    const int ar = tid >> 2, ak = (tid & 3) * 4;
    const float* aptr = (m0 + ar < Mvalid) ? arow(m0 + ar) : nullptr;
    const int br = tid >> 4, bc = (tid & 15) * 4;
    const bool bok = tid < 256 && (n0 + bc) < N;
    for (int k0 = 0; k0 < K; k0 += 16) {
        float4 av = make_float4(0.f, 0.f, 0.f, 0.f), bv = make_float4(0.f, 0.f, 0.f, 0.f);
        if (aptr) av = *(const float4*)(aptr + k0 + ak);
        if (bok) bv = *(const float4*)(Bm + (size_t)(k0 + br) * ldb + n0 + bc);
        __syncthreads();
        As[ak + 0][ar] = av.x; As[ak + 1][ar] = av.y; As[ak + 2][ar] = av.z; As[ak + 3][ar] = av.w;
        if (tid < 256) *(float4*)&Bs[br][bc] = bv;
        __syncthreads();
#pragma unroll
        for (int kk = 0; kk < 16; ++kk) {
            const float4 a = *(const float4*)&As[kk][ty * 4];
            const float4 b = *(const float4*)&Bs[kk][tx * 4];
            const float aa[4] = {a.x, a.y, a.z, a.w}, bb[4] = {b.x, b.y, b.z, b.w};
#pragma unroll
            for (int i = 0; i < 4; ++i)
#pragma unroll
                for (int j = 0; j < 4; ++j) acc[i][j] += aa[i] * bb[j];
        }
    }
#pragma unroll
    for (int i = 0; i < 4; ++i) {
        const int m = m0 + ty * 4 + i;
        if (m < Mvalid) {
#pragma unroll
            for (int j = 0; j < 4; ++j) { const int n = n0 + tx * 4 + j; if (n < N) epi(m, n, acc[i][j]); }
        }
    }
    __syncthreads();
}

template <class ARow, class Epi>
__device__ void gemm_f32(ARow arow, const float* Bm, int ldb, int M, int N, int K, Epi epi, float* lds) {
    const int nM = (M + 127) / 128, nN = (N + 63) / 64;
    for (int u = blockIdx.x; u < nM * nN; u += gridDim.x) {
        const int mt = u / nN, nt = u % nN;
        gemm_tile_f32(arow, Bm, ldb, K, N, mt * 128, nt * 64, M, epi, lds);
    }
}

__device__ __forceinline__ float log_sigmoid(float x) { return fminf(x, 0.f) - log1pf(__expf(-fabsf(x))); }
__device__ void ph_postproj(const P& p) {
    const int tid = threadIdx.x, w = tid >> 6, lane = tid & 63;
    for (int t = blockIdx.x; t < T; t += gridDim.x) {
        float* row = p.proj + (size_t)t * D_IN;
        for (int hh = w; hh < 28; hh += 8) {
            int off; const float* gw;
            if (hh < 8) { off = OFF_QN + hh * DH; gw = p.nsa_q_norm; }
            else if (hh < 10) { off = OFF_KS + (hh - 8) * DH; gw = p.nsa_k_norm + 1 * DH; }
            else if (hh < 12) { off = OFF_KW + (hh - 10) * DH; gw = p.nsa_k_norm + 2 * DH; }
            else if (hh < 20) { off = OFF_QF + (hh - 12) * DH; gw = p.fox_q_norm; }
            else { off = OFF_KF + (hh - 20) * DH; gw = p.fox_k_norm; }
            const float a = row[off + lane], b = row[off + 64 + lane];
            const float ss = wave_sum(a * a + b * b);
            const float rs = rsqrtf(ss / DH + EPS);
            row[off + lane] = a * rs * gw[lane];
            row[off + 64 + lane] = b * rs * gw[64 + lane];
        }
        if (tid < 24) { const float v = row[OFF_GN + tid] + p.b_nsa_gate[tid]; row[OFF_GN + tid] = 1.f / (1.f + __expf(-v)); }
        if (tid >= 64 && tid < 72) { const int hh = tid - 64; row[OFF_FF + hh] = log_sigmoid(row[OFF_FF + hh] + p.fox_forget_bias[hh]); }
    }
}

__device__ void ph_cumsum(const P& p, float* lds) {
    const int tid = threadIdx.x;
    for (int u = blockIdx.x; u < NB * 8; u += gridDim.x) {
        const int b = u >> 3, hh = u & 7;
        float v[4]; float s = 0.f;
#pragma unroll
        for (int i = 0; i < 4; ++i) { v[i] = p.proj[(size_t)(b * S + tid * 4 + i) * D_IN + OFF_FF + hh]; s += v[i]; v[i] = s; }
        __syncthreads();
        lds[tid] = s;
        __syncthreads();
        if (tid == 0) { float r = 0.f; for (int i = 0; i < NTHR; ++i) { const float q = lds[i]; lds[i] = r; r += q; } }
        __syncthreads();
        const float base = lds[tid];
#pragma unroll
        for (int i = 0; i < 4; ++i) p.cum[(size_t)u * S + tid * 4 + i] = base + v[i];
        __syncthreads();
    }
}

__device__ void ph_flat(const P& p) {
    const int tid = threadIdx.x;
    for (int u = blockIdx.x; u < 2 * CMPR; u += gridDim.x) {
        const int kv = u / CMPR, row = u % CMPR;
        const int g = row % G, n = (row / G) % NCMP, b = row / (G * NCMP);
        const float* pos = kv ? p.cmp_pos_v : p.cmp_pos_k;
        const int off = (kv ? OFF_VC : OFF_KC) + g * DH;
        float* dst = p.flat + (size_t)u * 4096;
        for (int i = tid; i < 4096; i += NTHR) {
            const int l = i >> 7, d = i & 127;
            dst[i] = p.proj[(size_t)(b * S + 16 * n + l) * D_IN + off + d] + pos[l * DH + d];
        }
    }
}
__device__ __forceinline__ float gelu_tanh(float x) {
    const float u = 0.7978845608028654f * (x + 0.044715f * x * x * x);
    return 0.5f * x * (1.f + tanhf(u));
}
__device__ void ph_kcnorm(const P& p) {
    const int tid = threadIdx.x, w = tid >> 6, lane = tid & 63;
    for (int r = blockIdx.x * 8 + w; r < CMPR; r += gridDim.x * 8) {
        float* row = p.cmp + (size_t)r * DH;
        const float a = row[lane], b = row[64 + lane];
        const float rs = rsqrtf(wave_sum(a * a + b * b) / DH + EPS);
        row[lane] = a * rs * p.nsa_k_norm[lane];
        row[64 + lane] = b * rs * p.nsa_k_norm[64 + lane];
    }
}

__device__ void ph_cmpattn(const P& p, float* lds) {
    const int tid = threadIdx.x, w = tid >> 6, lane = tid & 63;
    float* qs = lds + w * 1280;
    float* ps = qs + 512;
    float* psum = ps + 512;
    float* impb = psum + 128;
    for (int u = blockIdx.x * 8 + w; u < T * G; u += gridDim.x * 8) {
        const int g = u % G, t = (u / G) % S, b = u / (G * S);
        const float* qrow = p.proj + (size_t)(b * S + t) * D_IN + OFF_QN + g * R * DH;
        for (int i = lane; i < 512; i += 64) qs[i] = qrow[i];
        const float* kc = p.cmp;
        const float* vc = p.cmp + (size_t)CMPR * DH;
        float lg[2][4];
#pragma unroll
        for (int j = 0; j < 2; ++j) {
            const int n = lane + 64 * j;
            float a[4] = {0.f, 0.f, 0.f, 0.f};
            if (n < NCMP) {
                const float* kr = kc + (size_t)((b * NCMP + n) * G + g) * DH;
#pragma unroll 2
                for (int d = 0; d < DH; d += 4) {
                    const float4 kk = *(const float4*)(kr + d);
#pragma unroll
                    for (int r = 0; r < 4; ++r) {
                        const float4 qq = *(const float4*)(qs + r * DH + d);
                        a[r] += qq.x * kk.x + qq.y * kk.y + qq.z * kk.z + qq.w * kk.w;
                    }
                }
            }
            const int dist = t - (16 * n + 31);
            const bool ok = n < NCMP && dist >= 0;
#pragma unroll
            for (int r = 0; r < 4; ++r)
                lg[j][r] = ok ? a[r] * SCALE + p.rel_bias[t5bucket(dist) * 8 + g * R + r] : -1e30f;
        }
        const bool any = t >= 31;
        float pr[2][4];
#pragma unroll
        for (int r = 0; r < 4; ++r) {
            const float m = wave_max(fmaxf(lg[0][r], lg[1][r]));
            float e0 = lg[0][r] > -1e29f ? __expf(lg[0][r] - m) : 0.f;
            float e1 = lg[1][r] > -1e29f ? __expf(lg[1][r] - m) : 0.f;
            const float sum = wave_sum(e0 + e1);
            const float inv = any ? 1.f / sum : 0.f;
            pr[0][r] = e0 * inv; pr[1][r] = e1 * inv;
            ps[r * 128 + lane] = pr[0][r]; ps[r * 128 + 64 + lane] = pr[1][r];
        }
        psum[lane] = pr[0][0] + pr[0][1] + pr[0][2] + pr[0][3];
        psum[64 + lane] = pr[1][0] + pr[1][1] + pr[1][2] + pr[1][3];
        float o[4][2] = {};
        const int nmax = any ? min(NCMP, (t - 31) / 16 + 1) : 0;
#pragma unroll 2
        for (int n = 0; n < nmax; ++n) {
            const float2 vv = *(const float2*)(vc + (size_t)((b * NCMP + n) * G + g) * DH + 2 * lane);
#pragma unroll
            for (int r = 0; r < 4; ++r) { const float pp = ps[r * 128 + n]; o[r][0] += pp * vv.x; o[r][1] += pp * vv.y; }
        }
#pragma unroll
        for (int r = 0; r < 4; ++r)
            *(float2*)(p.ocmp + (size_t)(b * S + t) * 1024 + (g * R + r) * DH + 2 * lane) = make_float2(o[r][0], o[r][1]);
        const int cur = t >> 6;
        float imp = 0.f;
        if (lane < 32) {
            const int j = lane;
            for (int n = 4 * j - 1; n <= 4 * j + 3; ++n) if (n >= 0 && n < NCMP) imp += psum[n];
            const bool forced = (j == 0) || (j == cur) || (j == cur - 1);
            const bool valid = j <= cur;
            imp = forced ? 1e6f : (valid ? imp : -1e6f);
            impb[j] = imp;
        }
        unsigned mask = 0;
        {
            int rank = 0;
            if (lane < 32) {
#pragma unroll 4
                for (int j2 = 0; j2 < 32; ++j2) { const float v2 = impb[j2]; rank += (v2 > imp || (v2 == imp && j2 < lane)) ? 1 : 0; }
            }
            const unsigned long long bal = __ballot(lane < 32 && rank < 16);
            mask = (unsigned)bal;
        }
        if (lane == 0) p.sel[(size_t)(b * G + g) * S + t] = mask;
    }
}

template <int MODE>
__device__ void ph_attn(const P& p, float* lds) {
    const int tid = threadIdx.x, w = tid >> 6, lane = tid & 63;
    float* qs = lds + w * 192;
    float* ps = qs + 128;
    for (int u = blockIdx.x * 8 + w; u < T * 8; u += gridDim.x * 8) {
        const int h = u & 7, t = (u >> 3) % S, b = u / (8 * S);
        const int g = h / R;
        const int qoff = MODE == 2 ? OFF_QF + h * DH : OFF_QN + h * DH;
        const int koff = MODE == 0 ? OFF_KW + g * DH : MODE == 1 ? OFF_KS + g * DH : OFF_KF + h * DH;
        const int voff = MODE == 0 ? OFF_VW + g * DH : MODE == 1 ? OFF_VS + g * DH : OFF_VF + h * DH;
        const float* base = p.proj + (size_t)b * S * D_IN;
        qs[lane] = base[(size_t)t * D_IN + qoff + lane];
        qs[64 + lane] = base[(size_t)t * D_IN + qoff + 64 + lane];
        unsigned selm = 0xffffffffu;
        if (MODE == 1) selm = p.sel[(size_t)(b * G + g) * S + t];
        const float* cumr = p.cum + (size_t)(b * 8 + h) * S;
        float cq = 0.f; if (MODE == 2) cq = cumr[t];
        int jlo = 0; const int jhi = t >> 6;
        if (MODE == 0) { const int lo = t - 511; jlo = lo > 0 ? (lo >> 6) : 0; }
        float m = -1e30f, l = 0.f, o0 = 0.f, o1 = 0.f;
        for (int j = jlo; j <= jhi; ++j) {
            if (MODE == 1 && !((selm >> j) & 1u)) continue;
            const int s = j * 64 + lane;
            bool ok = s <= t;
            if (MODE == 0) ok = ok && (t - s) < 512;
            float lgt = -1e30f;
            if (ok) {
                const float* kr = base + (size_t)s * D_IN + koff;
                float a = 0.f;
                for (int d = 0; d < DH; d += 4) {
                    const float4 kk = *(const float4*)(kr + d);
                    const float4 qq = *(const float4*)(qs + d);
                    a += qq.x * kk.x + qq.y * kk.y + qq.z * kk.z + qq.w * kk.w;
                }
                if (MODE == 2) lgt = a * SCALE + cq - cumr[s];
                else lgt = a * SCALE + p.rel_bias[t5bucket(t - s) * 8 + h];
            }
            const float mt = wave_max(lgt);
            const float mn = fmaxf(m, mt);
            const float alpha = __expf(m - mn);
            const float pp = ok ? __expf(lgt - mn) : 0.f;
            l = l * alpha + wave_sum(pp);
            o0 *= alpha; o1 *= alpha; m = mn;
            ps[lane] = pp;
            const int ns = min(64, t - j * 64 + 1);
            for (int i = 0; i < ns; ++i) {
                const float2 vv = *(const float2*)(base + (size_t)(j * 64 + i) * D_IN + voff + 2 * lane);
                const float q = ps[i];
                o0 += q * vv.x; o1 += q * vv.y;
            }
        }
        float* od = (MODE == 0 ? p.owin : MODE == 1 ? p.oslc : p.ofox) + (size_t)(b * S + t) * 1024 + h * DH + 2 * lane;
        const float inv = 1.f / l;
        *(float2*)od = make_float2(o0 * inv, o1 * inv);
    }
}

__device__ void ph_combine(const P& p, float* lds) {
    const int tid = threadIdx.x;
    for (int t = blockIdx.x; t < T; t += gridDim.x) {
        const float* gates = p.proj + (size_t)t * D_IN + OFF_GN;
        const int i0 = tid * 2, hh = i0 >> 7;
        const float g0 = gates[hh], g1 = gates[8 + hh], g2 = gates[16 + hh];
        const size_t o = (size_t)t * 1024 + i0;
        const float a0 = g0 * p.ocmp[o] + g1 * p.oslc[o] + g2 * p.owin[o];
        const float a1 = g0 * p.ocmp[o + 1] + g1 * p.oslc[o + 1] + g2 * p.owin[o + 1];
        const float f0 = p.ofox[o], f1 = p.ofox[o + 1];
        const float sa = block_sum(a0 * a0 + a1 * a1, lds);
        const float sf = block_sum(f0 * f0 + f1 * f1, lds + 16);
        const float ra = rsqrtf(sa / 1024.f + EPS), rf = rsqrtf(sf / 1024.f + EPS);
        float* mo = p.mix + (size_t)t * D;
        mo[i0] = a0 * ra * p.out_norm[i0]; mo[i0 + 1] = a1 * ra * p.out_norm[i0 + 1];
        mo[1024 + i0] = f0 * rf * p.out_norm[1024 + i0]; mo[1024 + i0 + 1] = f1 * rf * p.out_norm[1024 + i0 + 1];
    }
}

__device__ void ph_router(const P& p, float* lds) {
    const int tid = threadIdx.x, e = tid & 31, ks = tid >> 5;
    for (int t = blockIdx.x; t < T; t += gridDim.x) {
        const float* hr = p.h2 + (size_t)t * D;
        float a = 0.f;
        for (int k = ks * 128; k < ks * 128 + 128; ++k) a += hr[k] * p.router_w[k * NE + e];
        __syncthreads();
        lds[ks * 32 + e] = a;
        __syncthreads();
        if (tid < 32) {
            float s = p.router_b[tid];
            for (int i = 0; i < 16; ++i) s += lds[i * 32 + tid];
            lds[512 + tid] = s;
        }
        __syncthreads();
        if (tid < 64) {
            float v = tid < 32 ? lds[512 + tid] : -3.4e38f;
            int ti[4]; float tv[4];
#pragma unroll
            for (int k = 0; k < 4; ++k) {
                const float m = wave_max(v);
                const unsigned long long bal = __ballot(v == m);
                const int bi = __ffsll((long long)bal) - 1;
                ti[k] = bi; tv[k] = m;
                if (tid == bi) v = -3.4e38f;
            }
            float den = 0.f, ex[4];
#pragma unroll
            for (int k = 0; k < 4; ++k) { ex[k] = __expf(tv[k] - tv[0]); den += ex[k]; }
            if (tid == 0) {
#pragma unroll
                for (int k = 0; k < 4; ++k) {
                    p.topi[t * 4 + k] = ti[k]; p.topw[t * 4 + k] = ex[k] / den;
                    const int slot = atomicAdd(&p.cnt[ti[k]], 1);
                    p.list[ti[k] * T + slot] = t * 4 + k;
                }
            }
        }
    }
}

#define LDS_DECL extern __shared__ __attribute__((aligned(16))) float lds[]
__global__ void __launch_bounds__(NTHR) k_mod(P p) { LDS_DECL; ph_mod(p, lds); }
__global__ void __launch_bounds__(NTHR) k_rms1(P p) { LDS_DECL; ph_rmsmod(p.x, p.norm_attn, p.mod, 0, 1, p.h, lds); }
__global__ void __launch_bounds__(NTHR) k_inproj(P p) {
    LDS_DECL;
    const float* A = p.h; float* C = p.proj;
    gemm_f32([=](int m) { return A + (size_t)m * D; }, p.w_in, D_IN, T, D_IN, D,
             [=](int m, int n, float v) { C[(size_t)m * D_IN + n] = v; }, lds);
}
__global__ void __launch_bounds__(NTHR) k_postproj(P p) { ph_postproj(p); }
__global__ void __launch_bounds__(NTHR) k_cumsum(P p) { LDS_DECL; ph_cumsum(p, lds); }
__global__ void __launch_bounds__(NTHR) k_flat(P p) { ph_flat(p); }
__global__ void __launch_bounds__(NTHR) k_cmp1(P p, int kv) {
    LDS_DECL;
    const float* A = p.flat + (size_t)kv * CMPR * 4096; float* C = p.hid + (size_t)kv * CMPR * CMPH;
    gemm_f32([=](int m) { return A + (size_t)m * 4096; }, kv ? p.cmp_v_w1 : p.cmp_k_w1, CMPH, CMPR, CMPH, 4096,
             [=](int m, int n, float v) { C[(size_t)m * CMPH + n] = gelu_tanh(v); }, lds);
}
__global__ void __launch_bounds__(NTHR) k_cmp2(P p, int kv) {
    LDS_DECL;
    const float* A = p.hid + (size_t)kv * CMPR * CMPH; float* C = p.cmp + (size_t)kv * CMPR * DH;
    gemm_f32([=](int m) { return A + (size_t)m * CMPH; }, kv ? p.cmp_v_w2 : p.cmp_k_w2, DH, CMPR, DH, CMPH,
             [=](int m, int n, float v) { C[(size_t)m * DH + n] = v; }, lds);
}
__global__ void __launch_bounds__(NTHR) k_kcnorm(P p) { ph_kcnorm(p); }
__global__ void __launch_bounds__(NTHR) k_cmpattn(P p) { LDS_DECL; ph_cmpattn(p, lds); }
template <int MODE> __global__ void __launch_bounds__(NTHR) k_attn(P p) { LDS_DECL; ph_attn<MODE>(p, lds); }
__global__ void __launch_bounds__(NTHR) k_combine(P p) { LDS_DECL; ph_combine(p, lds); }
__global__ void __launch_bounds__(NTHR) k_outproj(P p) {
    LDS_DECL;
    const float* A = p.mix; float* C = p.x1; const float* X = p.x; const float* mod = p.mod;
    gemm_f32([=](int m) { return A + (size_t)m * D; }, p.w_out, D, T, D, D,
             [=](int m, int n, float v) { C[(size_t)m * D + n] = X[(size_t)m * D + n] + mod[(size_t)(m / S) * 6 * D + 2 * D + n] * v; }, lds);
}
__global__ void __launch_bounds__(NTHR) k_rms2(P p) { LDS_DECL; ph_rmsmod(p.x1, p.norm_moe, p.mod, 3, 4, p.h2, lds); }
__global__ void __launch_bounds__(NTHR) k_router(P p) { LDS_DECL; ph_router(p, lds); }
__global__ void __launch_bounds__(NTHR) k_up(P p) {
    LDS_DECL;
    for (int u = blockIdx.x; u < NE * 64 * 64; u += gridDim.x) {
        const int nt = u & 63, mt = (u >> 6) & 63, e = u >> 12;
        const int ce = p.cnt[e];
        if (mt * 128 >= ce) continue;
        const int* lst = p.list + e * T; const float* H2 = p.h2; float* HU = p.hu; const float* bu = p.b_up + (size_t)e * 2 * F;
        gemm_tile_f32([=](int m) { return H2 + (size_t)(lst[m] >> 2) * D; }, p.w_up + (size_t)e * D * 2 * F, 2 * F, D, 2 * F, mt * 128, nt * 64, ce,
                      [=](int m, int n, float v) { HU[(size_t)lst[m] * 2 * F + n] = v + bu[n]; }, lds);
    }
}
__global__ void __launch_bounds__(NTHR) k_act(P p) {
    for (size_t i = (size_t)blockIdx.x * NTHR + threadIdx.x; i < (size_t)TK * F; i += (size_t)gridDim.x * NTHR) {
        const size_t a = i / F; const int n = (int)(i % F);
        const float gl = fminf(p.hu[a * 2 * F + n], 7.f);
        const float li = fminf(fmaxf(p.hu[a * 2 * F + F + n], -7.f), 7.f);
        p.act[i] = gl * (1.f / (1.f + __expf(-1.702f * gl))) * (li + 1.f);
    }
}
__global__ void __launch_bounds__(NTHR) k_down(P p) {
    LDS_DECL;
    for (int u = blockIdx.x; u < NE * 64 * 32; u += gridDim.x) {
        const int nt = u & 31, mt = (u >> 5) & 63, e = u >> 11;
        const int ce = p.cnt[e];
        if (mt * 128 >= ce) continue;
        const int* lst = p.list + e * T; const float* ACT = p.act; float* Y = p.y; const float* bd = p.b_down + (size_t)e * D; const float* tw = p.topw;
        gemm_tile_f32([=](int m) { return ACT + (size_t)lst[m] * F; }, p.w_down + (size_t)e * F * D, D, F, D, mt * 128, nt * 64, ce,
                      [=](int m, int n, float v) { const int a = lst[m]; Y[(size_t)a * D + n] = (v + bd[n]) * tw[a]; }, lds);
    }
}
__global__ void __launch_bounds__(NTHR) k_final(P p) {
    for (size_t i = (size_t)blockIdx.x * NTHR + threadIdx.x; i < (size_t)T * D; i += (size_t)gridDim.x * NTHR) {
        const size_t t = i / D; const int n = (int)(i % D);
        const float s = p.y[(t * 4 + 0) * D + n] + p.y[(t * 4 + 1) * D + n] + p.y[(t * 4 + 2) * D + n] + p.y[(t * 4 + 3) * D + n];
        p.out[i] = p.x1[i] + p.mod[(t / S) * 6 * D + 5 * D + n] * s;
    }
}
}

extern "C" void kernel_launch(void* const* d_in, const int* in_sizes, int n_in, void* d_out, int out_size, void* d_ws, size_t ws_size,
                              hipStream_t stream) {
    (void)in_sizes; (void)n_in; (void)out_size; (void)ws_size;
    P p{};
    const float* const* in = (const float* const*)d_in;
    p.x = in[0]; p.c = in[1]; p.rel_bias = in[2]; p.mod_w = in[3]; p.mod_b = in[4]; p.norm_attn = in[5]; p.norm_moe = in[6]; p.w_in = in[7];
    p.b_nsa_gate = in[8]; p.nsa_q_norm = in[9]; p.nsa_k_norm = in[10]; p.cmp_pos_k = in[11]; p.cmp_pos_v = in[12]; p.cmp_k_w1 = in[13];
    p.cmp_k_w2 = in[14]; p.cmp_v_w1 = in[15]; p.cmp_v_w2 = in[16]; p.fox_q_norm = in[17]; p.fox_k_norm = in[18]; p.fox_forget_bias = in[19];
    p.out_norm = in[20]; p.w_out = in[21]; p.router_w = in[22]; p.router_b = in[23]; p.w_up = in[24]; p.b_up = in[25]; p.w_down = in[26];
    p.b_down = in[27];
    p.out = (float*)d_out;
    char* ws = (char*)d_ws; size_t off = 0;
    auto take = [&](size_t bytes) { void* r = ws + off; off += (bytes + 255) & ~(size_t)255; return r; };
    p.cnt = (int*)take(NE * sizeof(int));
    p.mod = (float*)take((size_t)NB * 6 * D * 4);
    p.h = (float*)take((size_t)T * D * 4);
    p.proj = (float*)take((size_t)T * D_IN * 4);
    p.cum = (float*)take((size_t)NB * 8 * S * 4);
    p.flat = (float*)take((size_t)2 * CMPR * 4096 * 4);
    p.hid = (float*)take((size_t)2 * CMPR * CMPH * 4);
    p.cmp = (float*)take((size_t)2 * CMPR * DH * 4);
    p.ocmp = (float*)take((size_t)T * 1024 * 4);
    p.oslc = (float*)take((size_t)T * 1024 * 4);
    p.owin = (float*)take((size_t)T * 1024 * 4);
    p.ofox = (float*)take((size_t)T * 1024 * 4);
    p.mix = (float*)take((size_t)T * D * 4);
    p.x1 = (float*)take((size_t)T * D * 4);
    p.h2 = (float*)take((size_t)T * D * 4);
    p.topw = (float*)take((size_t)TK * 4);
    p.topi = (int*)take((size_t)TK * 4);
    p.sel = (unsigned*)take((size_t)NB * G * S * 4);
    p.list = (int*)take((size_t)NE * T * 4);
    p.hu = (float*)take((size_t)TK * 2 * F * 4);
    p.act = (float*)take((size_t)TK * F * 4);
    p.y = (float*)take((size_t)TK * D * 4);

    hipMemsetAsync(p.cnt, 0, NE * sizeof(int), stream);
    const int GR = 2048; const size_t L = 32768;
    k_mod<<<192, NTHR, L, stream>>>(p);
    k_rms1<<<GR, NTHR, L, stream>>>(p);
    k_inproj<<<GR, NTHR, L, stream>>>(p);
    k_postproj<<<GR, NTHR, L, stream>>>(p);
    k_cumsum<<<32, NTHR, L, stream>>>(p);
    k_flat<<<GR, NTHR, L, stream>>>(p);
    k_cmp1<<<32, NTHR, L, stream>>>(p, 0);
    k_cmp1<<<32, NTHR, L, stream>>>(p, 1);
    k_cmp2<<<16, NTHR, L, stream>>>(p, 0);
    k_cmp2<<<16, NTHR, L, stream>>>(p, 1);
    k_kcnorm<<<127, NTHR, L, stream>>>(p);
    k_cmpattn<<<GR, NTHR, 49152, stream>>>(p);
    k_attn<0><<<GR * 2, NTHR, L, stream>>>(p);
    k_attn<1><<<GR * 2, NTHR, L, stream>>>(p);
    k_attn<2><<<GR * 2, NTHR, L, stream>>>(p);
    k_combine<<<GR, NTHR, L, stream>>>(p);
    k_outproj<<<GR, NTHR, L, stream>>>(p);
    k_rms2<<<GR, NTHR, L, stream>>>(p);
    k_router<<<GR, NTHR, L, stream>>>(p);
    k_up<<<GR * 2, NTHR, L, stream>>>(p);
    k_act<<<GR * 2, NTHR, L, stream>>>(p);
    k_down<<<GR * 2, NTHR, L, stream>>>(p);
    k_final<<<GR * 2, NTHR, L, stream>>>(p);
}
```

```cpp
#include <hip/hip_runtime.h>
#include <stdint.h>
#include <stdio.h>

#define XB_TMO      128
#define XB_XCNT(j)  (256  + 64 * (j))
#define XB_XSUB(j)  (1280 + 64 * (j))
#define XB_XGEN(j)  (2304 + 64 * (j))
#define XB_TOP      3328
#define XB_TOPGEN   3392
#define XCD_BAR_WORDS 3456
#define XB_SPIN_CAP (1u << 18)
#define LAS __attribute__((address_space(3)))

__device__ __forceinline__ unsigned xb_ld(unsigned* p)              { return __hip_atomic_load(p, __ATOMIC_RELAXED, __HIP_MEMORY_SCOPE_AGENT); }
__device__ __forceinline__ unsigned xb_add(unsigned* p, unsigned v) { return __hip_atomic_fetch_add(p, v, __ATOMIC_RELAXED, __HIP_MEMORY_SCOPE_AGENT); }
__device__ __forceinline__ unsigned xb_xcc_id() { return (unsigned)__builtin_amdgcn_s_getreg((3 << 11) | 20) & 0xFu; }
#define XB_SPIN(cond, bar) do { unsigned _sp = 0; while (cond) { __builtin_amdgcn_s_sleep(1); \
    if ((++_sp & 255u) == 0u) { if (xb_ld(&(bar)[XB_TMO])) break; if (_sp > XB_SPIN_CAP) { atomicAdd(&(bar)[XB_TMO], 1u); break; } } } } while (0)

struct XcdBarrier {
    unsigned* bar; unsigned x;
    volatile LAS unsigned* st;
};

__device__ __forceinline__ XcdBarrier xcd_barrier_post(unsigned* bar, volatile LAS unsigned* st) {
    XcdBarrier b; b.bar = bar; b.x = xb_xcc_id(); b.st = st;
    if (threadIdx.x == 0) (void)xb_add(&bar[XB_XCNT(b.x)], 1u);
    return b;
}
__device__ __forceinline__ void xcd_barrier_complete(unsigned* bar, unsigned x, unsigned& nloc, unsigned& nx) {
    const unsigned G = gridDim.x * gridDim.y * gridDim.z;
    unsigned sum, cnt, mine, sp = 0u;
    for (;;) {
        sum = 0u; cnt = 0u; mine = 0u;
#pragma unroll
        for (unsigned j = 0; j < 16; ++j) { const unsigned c = xb_ld(&bar[XB_XCNT(j)]); sum += c; cnt += (c > 0u) ? 1u : 0u; mine = (j == x) ? c : mine; }
        if (sum == G) break;
        __builtin_amdgcn_s_sleep(1);
        if ((++sp & 255u) == 0u) { if (xb_ld(&bar[XB_TMO])) break; if (sp > XB_SPIN_CAP) { atomicAdd(&bar[XB_TMO], 1u); break; } }
    }
    nloc = mine > 0u ? mine : 1u; nx = cnt > 0u ? cnt : 1u;
}

__device__ __forceinline__ void xcd_barrier(const XcdBarrier& b) {
    asm volatile("s_waitcnt vmcnt(0)" ::: "memory");
    __syncthreads();
    if (threadIdx.x == 0) {
        unsigned* bar = b.bar;
        __builtin_amdgcn_s_waitcnt(0);
        unsigned nloc = b.st[0], nx = b.st[1];
        if (nloc == 0u) { xcd_barrier_complete(bar, b.x, nloc, nx); b.st[0] = nloc; b.st[1] = nx; }
        const unsigned old = xb_add(&bar[XB_XSUB(b.x)], 1u);
        const unsigned gen = old / nloc;
        if (old + 1u == (gen + 1u) * nloc) {
            __builtin_amdgcn_fence(__ATOMIC_RELEASE, "agent");
            asm volatile("s_waitcnt vmcnt(0)" ::: "memory");
            const unsigned og = xb_add(&bar[XB_TOP], 1u);
            const unsigned tg = og / nx;
            if (og + 1u == (tg + 1u) * nx) xb_add(&bar[XB_TOPGEN], 1u);
            else XB_SPIN(xb_ld(&bar[XB_TOPGEN]) == tg, bar);
            __builtin_amdgcn_fence(__ATOMIC_ACQUIRE, "agent");
            xb_add(&bar[XB_XGEN(b.x)], 1u);
            asm volatile("s_waitcnt vmcnt(0)" ::: "memory");
        } else {
            XB_SPIN(xb_ld(&bar[XB_XGEN(b.x)]) == gen, bar);
            __builtin_amdgcn_fence(__ATOMIC_ACQUIRE, "agent");
            asm volatile("s_waitcnt vmcnt(0)" ::: "memory");
        }
    }
    __syncthreads();
}


namespace {
typedef unsigned short bf16_t;
typedef float f32x4 __attribute__((ext_vector_type(4)));
constexpr int D = 2048, NB = 4, S = 2048, T = NB * S;
constexpr int DH = 128, G = 2, R = 4;
constexpr int D_IN = 5664;
constexpr int OFF_QN = 0, OFF_KC = 1024, OFF_VC = 1280, OFF_KS = 1536, OFF_VS = 1792, OFF_KW = 2048, OFF_VW = 2304,
              OFF_QF = 2560, OFF_KF = 3584, OFF_VF = 4608, OFF_GN = 5632, OFF_FF = 5656;
__host__ __device__ constexpr int in_colmap(int n) { return n < 2560 ? n : n < 2584 ? 5632 + (n - 2560) : n < 5656 ? n - 24 : n; }
constexpr int NCMP = 127, CMPH = 256, CMPR = NB * NCMP * G;
constexpr int NE = 32, F = 2048, TK = T * 4;
constexpr float SCALE = 0.08838834764831845f;
constexpr float EPS = 1e-6f;
constexpr int NTHR = 512;

__device__ const unsigned char BUCKET[128] = {
 0, 1, 2, 3, 4, 5, 6, 7, 8, 9, 10, 11, 12, 13, 14, 15, 16, 16, 16, 17, 17, 18, 18, 18, 19, 19, 19, 20, 20, 20, 20, 21,
 21, 21, 21, 22, 22, 22, 22, 22, 23, 23, 23, 23, 23, 23, 24, 24, 24, 24, 24, 24, 25, 25, 25, 25, 25, 25, 25, 26, 26, 26, 26, 26,
 26, 26, 26, 27, 27, 27, 27, 27, 27, 27, 27, 27, 27, 28, 28, 28, 28, 28, 28, 28, 28, 28, 28, 29, 29, 29, 29, 29, 29, 29, 29, 29,
 29, 29, 29, 30, 30, 30, 30, 30, 30, 30, 30, 30, 30, 30, 30, 30, 30, 31, 31, 31, 31, 31, 31, 31, 31, 31, 31, 31, 31, 31, 31, 31};
__device__ __forceinline__ int t5bucket(int d) { return BUCKET[d > 127 ? 127 : d]; }

struct P {
    const float *x, *c, *rel_bias, *mod_w, *mod_b, *norm_attn, *norm_moe, *w_in, *b_nsa_gate, *nsa_q_norm, *nsa_k_norm,
        *cmp_pos_k, *cmp_pos_v, *cmp_k_w1, *cmp_k_w2, *cmp_v_w1, *cmp_v_w2, *fox_q_norm, *fox_k_norm, *fox_forget_bias,
        *out_norm, *w_out, *router_w, *router_b, *w_up, *b_up, *w_down, *b_down;
    float* out;
    float *mod, *cum, *row_w, *gatesf, *logf, *hidp, *bias1;
    int *cnt, *queue, *row_a; unsigned* bar; unsigned* sync;
    bf16_t *x1, *winT, *woutT, *w1T, *w2T, *hb, *projb, *mixb, *owinb, *oslcb, *ofoxb, *ocmpb, *cmpb;
    unsigned char *wupq, *wdnq, *xgq, *actq, *winq, *hq, *yq;
};

__device__ __forceinline__ float wave_sum(float v) {
#pragma unroll
    for (int o = 32; o > 0; o >>= 1) v += __shfl_xor(v, o);
    return v;
}
__device__ __forceinline__ float wave_max(float v) {
#pragma unroll
    for (int o = 32; o > 0; o >>= 1) v = fmaxf(v, __shfl_xor(v, o));
    return v;
}
__device__ __forceinline__ float bf2f(bf16_t v) { return __uint_as_float(((unsigned)v) << 16); }
__device__ __forceinline__ float bflo(unsigned w) { return __uint_as_float(w << 16); }
__device__ __forceinline__ float bfhi(unsigned w) { return __uint_as_float(w & 0xffff0000u); }
__device__ __forceinline__ unsigned pk_bf16(float lo, float hi) { unsigned r; asm("v_cvt_pk_bf16_f32 %0, %1, %2" : "=v"(r) : "v"(lo), "v"(hi)); return r; }
constexpr int IN_PAD = 5888;
__device__ __forceinline__ float block_sum(float v, float* red) {
    v = wave_sum(v);
    const int w = threadIdx.x >> 6;
    __syncthreads();
    if ((threadIdx.x & 63) == 0) red[w] = v;
    __syncthreads();
    float s = 0.f;
    for (int i = 0; i < (int)(blockDim.x >> 6); ++i) s += red[i];
    return s;
}

__device__ __forceinline__ void ph_mod(const P& p, float* lds) {
    const int tid = threadIdx.x, tx = tid & 15, ty = tid >> 4;
    float* sc = lds + 8192;
    if (blockIdx.x < 6 * D / 64) {
        for (int i = tid; i < 4 * D; i += NTHR) { const float cv = p.c[i]; sc[i] = cv / (1.f + __expf(-cv)); }
    }
    __syncthreads();
    for (int u = blockIdx.x; u < 6 * D / 64; u += gridDim.x) {
        const int n0 = u * 64 + tx * 4;
        float acc[4][4] = {};
        for (int k0 = ty * 64; k0 < ty * 64 + 64; k0 += 8) {
            float4 w[8];
#pragma unroll
            for (int i = 0; i < 8; ++i) w[i] = *(const float4*)(p.mod_w + (size_t)(k0 + i) * (6 * D) + n0);
#pragma unroll
            for (int i = 0; i < 8; ++i)
#pragma unroll
                for (int b = 0; b < 4; ++b) {
                    const float sv = sc[b * D + k0 + i];
                    acc[b][0] += sv * w[i].x; acc[b][1] += sv * w[i].y; acc[b][2] += sv * w[i].z; acc[b][3] += sv * w[i].w;
                }
        }
        __syncthreads();
#pragma unroll
        for (int b = 0; b < 4; ++b)
#pragma unroll
            for (int j = 0; j < 4; ++j) lds[(ty * 4 + b) * 64 + tx * 4 + j] = acc[b][j];
        __syncthreads();
        if (tid < 256) {
            const int b = tid >> 6, n = tid & 63;
            float s = 0.f;
            for (int i = 0; i < 32; ++i) s += lds[(i * 4 + b) * 64 + n];
            p.mod[b * 6 * D + u * 64 + n] = s + p.mod_b[u * 64 + n];
        }
    }
}

__device__ __forceinline__ void ph_rms1_b(const P& p, float* lds) {
    const int tid = threadIdx.x, w = tid >> 6, lane = tid & 63;
    for (int t = blockIdx.x * 8 + w; t < T; t += gridDim.x * 8) {
        const int b = t / S;
        f32x4 v[8]; float ss = 0.f;
#pragma unroll
        for (int i = 0; i < 8; ++i) { v[i] = *(const f32x4*)(p.x + (size_t)t * D + (i * 64 + lane) * 4); ss += v[i][0] * v[i][0] + v[i][1] * v[i][1] + v[i][2] * v[i][2] + v[i][3] * v[i][3]; }
        const float rs = rsqrtf(wave_sum(ss) / D + EPS);
        const float* scp = p.mod + (size_t)b * 6 * D + 1 * D; const float* shp = p.mod + (size_t)b * 6 * D;
#pragma unroll
        for (int i = 0; i < 8; ++i) {
            const int c = (i * 64 + lane) * 4;
            const f32x4 g = *(const f32x4*)(p.norm_attn + c), sc = *(const f32x4*)(scp + c), sh = *(const f32x4*)(shp + c);
            f32x4 o; for (int j = 0; j < 4; ++j) o[j] = v[i][j] * rs * g[j] * (1.f + sc[j]) + sh[j];
            int ow = 0; ow = __builtin_amdgcn_cvt_pk_fp8_f32(o[0], o[1], ow, false); ow = __builtin_amdgcn_cvt_pk_fp8_f32(o[2], o[3], ow, true);
            *(int*)(p.hq + (size_t)t * D + c) = ow;
            uint2 ob; ob.x = pk_bf16(o[0], o[1]); ob.y = pk_bf16(o[2], o[3]);
            *(uint2*)(p.hb + (size_t)t * D + c) = ob;
        }
    }
}

__device__ __forceinline__ float log_sigmoid(float x) { return fminf(x, 0.f) - log1pf(__expf(-fabsf(x))); }
__device__ __forceinline__ void ph_postproj(const P& p) {
    const int tid = threadIdx.x, w = tid >> 6, lane = tid & 63;
    for (int t = blockIdx.x * 8 + w; t < T; t += gridDim.x * 8) {
        bf16_t* row = p.projb + (size_t)t * IN_PAD;
        unsigned wv[28];
#pragma unroll
        for (int hh = 0; hh < 28; ++hh) {
            const int off = hh < 8 ? OFF_QN + hh * DH : hh < 10 ? OFF_KS + (hh - 8) * DH : hh < 12 ? OFF_KW + (hh - 10) * DH : hh < 20 ? OFF_QF + (hh - 12) * DH : OFF_KF + (hh - 20) * DH;
            wv[hh] = *(const unsigned*)(row + off + 2 * lane);
        }
        const float gate_in = lane < 24 ? bf2f(row[OFF_GN + lane]) : 0.f;
        const float f_in = lane < 8 ? bf2f(row[OFF_FF + lane]) : 0.f;
#pragma unroll
        for (int hh = 0; hh < 28; ++hh) {
            const int off = hh < 8 ? OFF_QN + hh * DH : hh < 10 ? OFF_KS + (hh - 8) * DH : hh < 12 ? OFF_KW + (hh - 10) * DH : hh < 20 ? OFF_QF + (hh - 12) * DH : OFF_KF + (hh - 20) * DH;
            const float* gw = hh < 8 ? p.nsa_q_norm : hh < 10 ? p.nsa_k_norm + DH : hh < 12 ? p.nsa_k_norm + 2 * DH : hh < 20 ? p.fox_q_norm : p.fox_k_norm;
            const float a = bflo(wv[hh]), b = bfhi(wv[hh]);
            const float rs = rsqrtf(wave_sum(a * a + b * b) / DH + EPS);
            const float2 g2 = *(const float2*)(gw + 2 * lane);
            *(unsigned*)(row + off + 2 * lane) = pk_bf16(a * rs * g2.x, b * rs * g2.y);
        }
        if (lane < 24) p.gatesf[(size_t)t * 24 + lane] = 1.f / (1.f + __expf(-(gate_in + p.b_nsa_gate[lane])));
        if (lane < 8) p.logf[(size_t)t * 8 + lane] = log_sigmoid(f_in + p.fox_forget_bias[lane]);
    }
}

__device__ __forceinline__ void ph_cumsum(const P& p, float* lds) {
    const int tid = threadIdx.x;
    for (int u = blockIdx.x; u < NB * 8; u += gridDim.x) {
        const int b = u >> 3, hh = u & 7;
        float v[4]; float s = 0.f;
#pragma unroll
        for (int i = 0; i < 4; ++i) { v[i] = p.logf[(size_t)(b * S + tid * 4 + i) * 8 + hh]; s += v[i]; v[i] = s; }
        __syncthreads();
        lds[tid] = s;
        __syncthreads();
        if (tid < 64) {
            float q[8], r = 0.f;
#pragma unroll
            for (int i = 0; i < 8; ++i) { q[i] = lds[tid * 8 + i]; r += q[i]; }
            float inc = r;
#pragma unroll
            for (int o = 1; o < 64; o <<= 1) { const float n = __shfl_up(inc, o); if (tid >= o) inc += n; }
            float run = inc - r;
#pragma unroll
            for (int i = 0; i < 8; ++i) { lds[tid * 8 + i] = run; run += q[i]; }
        }
        __syncthreads();
        const float base = lds[tid];
#pragma unroll
        for (int i = 0; i < 4; ++i) p.cum[(size_t)u * S + tid * 4 + i] = base + v[i];
        __syncthreads();
    }
}

__device__ __forceinline__ float gelu_tanh(float x) {
    const float u = 0.7978845608028654f * (x + 0.044715f * x * x * x);
    return 0.5f * x * (1.f + tanhf(u));
}
__device__ __forceinline__ void ph_combine(const P& p, float* lds) {
    const int tid = threadIdx.x, w = tid >> 6, lane = tid & 63;
    for (int t = blockIdx.x * 8 + w; t < T; t += gridDim.x * 8) {
        const float* gates = p.gatesf + (size_t)t * 24;
        float a[8][2], f[8][2]; float sa = 0.f, sf = 0.f;
#pragma unroll
        for (int i = 0; i < 8; ++i) {
            const size_t o = (size_t)t * 1024 + 2 * (i * 64 + lane);
            const float g0 = gates[i], g1 = gates[8 + i], g2 = gates[16 + i];
            const unsigned sw = *(const unsigned*)(p.oslcb + o), ww = *(const unsigned*)(p.owinb + o), fw = *(const unsigned*)(p.ofoxb + o);
            float c0, c1;
            { const unsigned cw = *(const unsigned*)(p.ocmpb + o); c0 = bflo(cw); c1 = bfhi(cw); }
            a[i][0] = g0 * c0 + g1 * bflo(sw) + g2 * bflo(ww); a[i][1] = g0 * c1 + g1 * bfhi(sw) + g2 * bfhi(ww);
            f[i][0] = bflo(fw); f[i][1] = bfhi(fw);
            sa += a[i][0] * a[i][0] + a[i][1] * a[i][1]; sf += f[i][0] * f[i][0] + f[i][1] * f[i][1];
        }
        const float ra = rsqrtf(wave_sum(sa) / 1024.f + EPS), rf = rsqrtf(wave_sum(sf) / 1024.f + EPS);
        bf16_t* mo = p.mixb + (size_t)t * D;
#pragma unroll
        for (int i = 0; i < 8; ++i) {
            const int c = 2 * (i * 64 + lane);
            const float2 n0 = *(const float2*)(p.out_norm + c), n1 = *(const float2*)(p.out_norm + 1024 + c);
            *(unsigned*)(mo + c) = pk_bf16(a[i][0] * ra * n0.x, a[i][1] * ra * n0.y);
            *(unsigned*)(mo + 1024 + c) = pk_bf16(f[i][0] * rf * n1.x, f[i][1] * rf * n1.y);
        }
    }
}

typedef short bf16x8 __attribute__((ext_vector_type(8)));
typedef float f32x16 __attribute__((ext_vector_type(16)));
typedef unsigned u32x4 __attribute__((ext_vector_type(4)));
typedef unsigned u32x2 __attribute__((ext_vector_type(2)));
typedef float f32x2 __attribute__((ext_vector_type(2)));

__device__ __forceinline__ unsigned cvt_pk_bf16(float lo, float hi) { unsigned r; asm("v_cvt_pk_bf16_f32 %0, %1, %2" : "=v"(r) : "v"(lo), "v"(hi)); return r; }
__device__ __forceinline__ float bf16_lo(unsigned w) { return __uint_as_float(w << 16); }
__device__ __forceinline__ float bf16_hi(unsigned w) { return __uint_as_float(w & 0xffff0000u); }
__device__ __forceinline__ float bf16_f(bf16_t v) { return __uint_as_float(((unsigned)v) << 16); }
__device__ __forceinline__ f32x4 bf16x4_f(u32x2 w) { return (f32x4){bf16_lo(w.x), bf16_hi(w.x), bf16_lo(w.y), bf16_hi(w.y)}; }

typedef int i32x8 __attribute__((ext_vector_type(8)));
typedef int i32x4 __attribute__((ext_vector_type(4)));
constexpr int F8_SCALE_W = 0x79797979, F8_SCALE_A = 0x7F7F7F7F;
constexpr float F8_WMUL = 64.f;
__device__ __forceinline__ int perm32(int rho) { const int n = rho >> 4, i = rho & 15; return 8 * (i >> 2) + 4 * n + (i & 3); }
constexpr unsigned long long CVT_IN_BF_TILES = 0x1FF0001CCC00ull, CVT_IN_F8_TILES = 0x1FFFF333FFull;
constexpr int CVT_N_IN_BF = 16, CVT_N_IN_F8 = 31;
__device__ __forceinline__ int nth_set_bit(unsigned long long m, int j) { int b = 0; for (;; ++b) if ((m >> b) & 1) { if (j-- == 0) break; } return b; }
constexpr int CVT_T_IN = 16 * CVT_N_IN_BF, CVT_T_INQ = 8 * CVT_N_IN_F8, CVT_T_OUT = 16 * 16, CVT_T_W1 = 32 * 2, CVT_T_W2 = 2 * 2, CVT_T_UP = 8 * 32, CVT_T_DN = 8 * 16;
constexpr int CVT_B_OUT = CVT_T_IN, CVT_B_W1K = CVT_B_OUT + CVT_T_OUT, CVT_B_W1V = CVT_B_W1K + CVT_T_W1, CVT_B_W2K = CVT_B_W1V + CVT_T_W1,
              CVT_B_W2V = CVT_B_W2K + CVT_T_W2, CVT_B_UP = CVT_B_W2V + CVT_T_W2, CVT_B_DN = CVT_B_UP + NE * CVT_T_UP, CVT_B_INQ = CVT_B_DN + NE * CVT_T_DN, CVT_TOTAL = CVT_B_INQ + CVT_T_INQ;

struct CvtTile { const float* src; bf16_t* dst; int ldn, K, nvalid, k0, n0, drow0, perm; };
__device__ __forceinline__ CvtTile cvt_decode(const P& p, int u) {
    CvtTile t; int local, nNt; int mode = 0; t.perm = (u >= CVT_B_INQ || u < CVT_B_OUT) ? 1 : 0;
    if (u < CVT_B_OUT) { local = u; nNt = CVT_N_IN_BF; t.src = p.w_in; t.dst = p.winT; t.ldn = D_IN; t.K = D; t.nvalid = D_IN; }
    else if (u >= CVT_B_INQ) { local = u - CVT_B_INQ; nNt = CVT_N_IN_F8; t.src = p.w_in; t.dst = (bf16_t*)p.winq; t.ldn = D_IN; t.K = D; t.nvalid = D_IN; }
    else if (u < CVT_B_W1K) { local = u - CVT_B_OUT; nNt = 16; t.src = p.w_out; t.dst = p.woutT; t.ldn = D; t.K = D; t.nvalid = D; }
    else if (u < CVT_B_W1V) { local = u - CVT_B_W1K; nNt = 2; t.src = p.cmp_k_w1; t.dst = p.w1T; t.ldn = CMPH; t.K = 4096; t.nvalid = CMPH; }
    else if (u < CVT_B_W2K) { local = u - CVT_B_W1V; nNt = 2; t.src = p.cmp_v_w1; t.dst = p.w1T + (size_t)CMPH * 4096; t.ldn = CMPH; t.K = 4096; t.nvalid = CMPH; }
    else if (u < CVT_B_W2V) { local = u - CVT_B_W2K; nNt = 2; t.src = p.cmp_k_w2; t.dst = p.w2T; t.ldn = DH; t.K = CMPH; t.nvalid = DH; }
    else if (u < CVT_B_UP) { local = u - CVT_B_W2V; nNt = 2; t.src = p.cmp_v_w2; t.dst = p.w2T + (size_t)256 * CMPH; t.ldn = DH; t.K = CMPH; t.nvalid = DH; }
    else if (u < CVT_B_DN) { const int l2 = u - CVT_B_UP, e = l2 / CVT_T_UP; local = l2 % CVT_T_UP; nNt = 32; mode = 1;
        t.src = p.w_up + (size_t)e * D * 2 * F; t.dst = (bf16_t*)(p.wupq + (size_t)e * 2 * F * D); t.ldn = 2 * F; t.K = D; t.nvalid = 2 * F; }
    else { const int l2 = u - CVT_B_DN, e = l2 / CVT_T_DN; local = l2 % CVT_T_DN; nNt = 16;
        t.src = p.w_down + (size_t)e * F * D; t.dst = (bf16_t*)(p.wdnq + (size_t)e * D * F); t.ldn = D; t.K = F; t.nvalid = D; }
    int nt = local % nNt; const int kt = local / nNt;
    if (u < CVT_B_OUT) nt = nth_set_bit(CVT_IN_BF_TILES, nt); else if (u >= CVT_B_INQ) nt = nth_set_bit(CVT_IN_F8_TILES, nt);
    t.k0 = kt * (u < CVT_B_UP ? 128 : 256); t.n0 = nt * 128;
    if (mode == 1) { const int n = t.n0; t.drow0 = n < F ? (n >> 7) * 256 : ((n - F) >> 7) * 256 + 128; }
    else t.drow0 = t.n0;
    return t;
}
__device__ __forceinline__ void cvt_load(const CvtTile& t, f32x4 (&v)[8]) {
    const int tid = threadIdx.x, ng = tid & 31, kg = tid >> 5;
    const int n = t.n0 + ng * 4;
    const float* s = t.src + (size_t)(t.k0 + kg * 8) * t.ldn + n;
    const bool ok = n < t.nvalid;
#pragma unroll
    for (int i = 0; i < 8; ++i) v[i] = ok ? __builtin_nontemporal_load((const f32x4*)(s + (size_t)i * t.ldn)) : (f32x4){0.f, 0.f, 0.f, 0.f};
}
__device__ __forceinline__ void cvt_pack(const f32x4 (&v)[8], char* ldsc, int ng, int kg) {
#pragma unroll
    for (int c = 0; c < 4; ++c) {
        u32x4 w;
        w.x = cvt_pk_bf16(v[0][c], v[1][c]); w.y = cvt_pk_bf16(v[2][c], v[3][c]);
        w.z = cvt_pk_bf16(v[4][c], v[5][c]); w.w = cvt_pk_bf16(v[6][c], v[7][c]);
        *(u32x4*)(ldsc + (ng * 4 + c) * 256 + ((kg ^ (ng & 15)) << 4)) = w;
    }
}
__device__ __forceinline__ void cvt_store(const CvtTile& cur, const char* ldsc, int tid) {
    const int kc = tid & 15;
#pragma unroll
    for (int i = 0; i < 4; ++i) {
        const int nr = (tid >> 4) + 32 * i;
        const u32x4 w = *(const u32x4*)(ldsc + nr * 256 + ((kc ^ ((nr >> 2) & 15)) << 4));
        const int drow = cur.perm ? in_colmap(cur.n0 + nr) : cur.drow0 + nr;
        *(u32x4*)(cur.dst + (size_t)drow * cur.K + cur.k0 + kc * 8) = w;
    }
}
__device__ __forceinline__ void cvt_load8(const CvtTile& t, f32x4 (&v)[16]) {
    const int tid = threadIdx.x, ng = tid & 31, kg = tid >> 5;
    const float* s = t.src + (size_t)(t.k0 + kg * 16) * t.ldn + t.n0 + ng * 4;
    const bool ok = t.n0 + ng * 4 < t.nvalid;
#pragma unroll
    for (int i = 0; i < 16; ++i) v[i] = ok ? __builtin_nontemporal_load((const f32x4*)(s + (size_t)i * t.ldn)) : (f32x4){0.f, 0.f, 0.f, 0.f};
}
__device__ __forceinline__ unsigned pack4_fp8(float a, float b, float c, float d) {
    int w = 0;
    w = __builtin_amdgcn_cvt_pk_fp8_f32(a, b, w, false);
    w = __builtin_amdgcn_cvt_pk_fp8_f32(c, d, w, true);
    return (unsigned)w;
}
__device__ __forceinline__ void cvt_pack8(const f32x4 (&v)[16], char* ldsc, int ng, int kg) {
#pragma unroll
    for (int c = 0; c < 4; ++c) {
        u32x4 w;
        w.x = pack4_fp8(v[0][c] * F8_WMUL, v[1][c] * F8_WMUL, v[2][c] * F8_WMUL, v[3][c] * F8_WMUL);
        w.y = pack4_fp8(v[4][c] * F8_WMUL, v[5][c] * F8_WMUL, v[6][c] * F8_WMUL, v[7][c] * F8_WMUL);
        w.z = pack4_fp8(v[8][c] * F8_WMUL, v[9][c] * F8_WMUL, v[10][c] * F8_WMUL, v[11][c] * F8_WMUL);
        w.w = pack4_fp8(v[12][c] * F8_WMUL, v[13][c] * F8_WMUL, v[14][c] * F8_WMUL, v[15][c] * F8_WMUL);
        *(u32x4*)(ldsc + (ng * 4 + c) * 256 + ((kg ^ (ng & 15)) << 4)) = w;
    }
}
__device__ __forceinline__ void cvt_store8(const CvtTile& cur, const char* ldsc, int tid) {
    const int kc = tid & 15;
    char* dst = (char*)cur.dst;
#pragma unroll
    for (int i = 0; i < 4; ++i) {
        const int nr = (tid >> 4) + 32 * i;
        const int ns = cur.perm ? nr : (nr & ~31) + perm32(nr & 31);
        const u32x4 w = *(const u32x4*)(ldsc + ns * 256 + ((kc ^ ((ns >> 2) & 15)) << 4));
        const int drow = cur.perm ? in_colmap(cur.n0 + nr) : cur.drow0 + nr;
        *(u32x4*)(dst + (size_t)drow * cur.K + cur.k0 + kc * 16) = w;
    }
}
__device__ __forceinline__ void ph_convert(const P& p, char* ldsc) {
    const int tid = threadIdx.x, ng = tid & 31, kg = tid >> 5, G_ = gridDim.x;
    {
        int u = blockIdx.x;
        if (u < CVT_B_UP) {
            CvtTile tA = cvt_decode(p, u), tB = tA;
            f32x4 vA[8], vB[8];
            cvt_load(tA, vA);
            bool hasB = u + G_ < CVT_B_UP;
            if (hasB) { tB = cvt_decode(p, u + G_); cvt_load(tB, vB); }
            int buf = 0;
            for (;;) {
                cvt_pack(vA, ldsc + buf * 32768, ng, kg);
                const CvtTile curA = tA;
                const bool hasA2 = u + 2 * G_ < CVT_B_UP;
                if (hasA2) { tA = cvt_decode(p, u + 2 * G_); cvt_load(tA, vA); }
                __syncthreads();
                cvt_store(curA, ldsc + buf * 32768, tid);
                buf ^= 1;
                if (!hasB) break;
                cvt_pack(vB, ldsc + buf * 32768, ng, kg);
                const CvtTile curB = tB;
                const bool hasB2 = u + 3 * G_ < CVT_B_UP;
                if (hasB2) { tB = cvt_decode(p, u + 3 * G_); cvt_load(tB, vB); }
                __syncthreads();
                cvt_store(curB, ldsc + buf * 32768, tid);
                buf ^= 1;
                if (!hasA2) break;
                hasB = hasB2;
                u += 2 * G_;
            }
        }
        __syncthreads();
    }
    {
        int* slot = (int*)(ldsc + 65536);
        int tick = 0;
        if (tid == 0) { slot[0] = atomicAdd(p.queue + 48, 1); slot[1] = atomicAdd(p.queue + 48, 1); tick = atomicAdd(p.queue + 48, 1); }
        __syncthreads();
        int uA = CVT_B_UP + __builtin_amdgcn_readfirstlane(slot[0]), uB = CVT_B_UP + __builtin_amdgcn_readfirstlane(slot[1]);
        if (uA < CVT_TOTAL) {
            CvtTile tA = cvt_decode(p, uA), tB = tA;
            f32x4 vA[16], vB[16];
            cvt_load8(tA, vA);
            bool hasB = uB < CVT_TOTAL;
            if (hasB) { tB = cvt_decode(p, uB); cvt_load8(tB, vB); }
            int buf = 0;
            for (;;) {
                cvt_pack8(vA, ldsc + buf * 32768, ng, kg);
                const CvtTile curA = tA;
                if (tid == 0) { slot[2] = tick; tick = atomicAdd(p.queue + 48, 1); }
                __syncthreads();
                uA = CVT_B_UP + __builtin_amdgcn_readfirstlane(slot[2]);
                const bool hasA2 = uA < CVT_TOTAL;
                if (hasA2) { tA = cvt_decode(p, uA); cvt_load8(tA, vA); }
                cvt_store8(curA, ldsc + buf * 32768, tid);
                buf ^= 1;
                if (!hasB) break;
                cvt_pack8(vB, ldsc + buf * 32768, ng, kg);
                const CvtTile curB = tB;
                if (tid == 0) { slot[3] = tick; tick = atomicAdd(p.queue + 48, 1); }
                __syncthreads();
                uB = CVT_B_UP + __builtin_amdgcn_readfirstlane(slot[3]);
                const bool hasB2 = uB < CVT_TOTAL;
                if (hasB2) { tB = cvt_decode(p, uB); cvt_load8(tB, vB); }
                cvt_store8(curB, ldsc + buf * 32768, tid);
                buf ^= 1;
                if (!hasA2) break;
                hasB = hasB2;
            }
        }
        __syncthreads();
    }
}

constexpr int G_BK = 64, G_HALF = 128, G_HTB = G_HALF * G_BK * 2  , GEMM_LDS = 8 * G_HTB;
__device__ __forceinline__ int lds_byte(int r, int c) { const int st = (r >> 4) * 2 + (c >> 5), rr = r & 15, cc = c & 31, ob = rr * 64 + cc * 2; return st * 1024 + (ob ^ (((ob >> 9) & 1) << 5)); }
__device__ __forceinline__ void stage_rc(int b, int& R, int& C) { const int st = b / 1024, sb = b % 1024, swz = sb ^ (((sb >> 9) & 1) << 5); R = (st >> 1) * 16 + swz / 64; C = (st & 1) * 32 + (swz % 64) / 2; }

struct GNoInit { __device__ __forceinline__ void operator()(f32x4 (&)[2][2][4][2], int, int, int, int) const {} };
template <bool F8, class RowOff, class KOff, class Epi, class Init = GNoInit>
__device__ __forceinline__ void gemm256(const bf16_t* A, RowOff rowoff, KOff koff, const bf16_t* Bt, int ldb, int K, char* shm, Epi epi, Init init = Init()) {
#define G_SA(b, h) (shm + ((b) * 2 + (h)) * G_HTB)
#define G_SB(b, h) (shm + (4 + (b) * 2 + (h)) * G_HTB)
#define G_STAGE_A(T_, P_, h_, kt_) do { const int _so = 2 * (int)koff(kt_); _Pragma("unroll") for (int _i = 0; _i < 2; ++_i) { const int _b = (T_) * 16 + _i * 8192; int _r, _c; stage_rc(_b, _r, _c); \
        __builtin_amdgcn_raw_ptr_buffer_load_lds(rsrcA, (__attribute__((address_space(3))) void*)((P_) + _b), 16, 2 * (int)(rowoff((h_) * G_HALF + _r) + _c), _so, 0, 0); } } while (0)
#define G_STAGE_B(T_, P_, h_, kt_) do { const int _so = 2 * ((h_) * G_HALF * ldb + (kt_) * G_BK); _Pragma("unroll") for (int _i = 0; _i < 2; ++_i) { const int _b = (T_) * 16 + _i * 8192; int _r, _c; stage_rc(_b, _r, _c); \
        __builtin_amdgcn_raw_ptr_buffer_load_lds(rsrcB, (__attribute__((address_space(3))) void*)((P_) + _b), 16, 2 * (_r * ldb + _c), _so, 0, 0); } } while (0)
#define G_LDA(dst, b, h) do { if (F8) { _Pragma("unroll") for (int m = 0; m < 4; ++m) { \
            const i32x4 lo_ = *reinterpret_cast<const i32x4*>(G_SA(b, h) + lds_byte(wr * 64 + m * 16 + fr, fq * 8)), hi_ = *reinterpret_cast<const i32x4*>(G_SA(b, h) + lds_byte(wr * 64 + m * 16 + fr, 32 + fq * 8)); \
            dst##8[m] = __builtin_shufflevector(lo_, hi_, 0, 1, 2, 3, 4, 5, 6, 7); } } \
        else { _Pragma("unroll") for (int m = 0; m < 4; ++m) _Pragma("unroll") for (int k = 0; k < 2; ++k) \
            dst[m][k] = *reinterpret_cast<const bf16x8*>(G_SA(b, h) + lds_byte(wr * 64 + m * 16 + fr, k * 32 + fq * 8)); } } while (0)
#define G_LDB(dst, b, h) do { if (F8) { _Pragma("unroll") for (int n = 0; n < 2; ++n) { \
            const i32x4 lo_ = *reinterpret_cast<const i32x4*>(G_SB(b, h) + lds_byte(wc * 32 + n * 16 + fr, fq * 8)), hi_ = *reinterpret_cast<const i32x4*>(G_SB(b, h) + lds_byte(wc * 32 + n * 16 + fr, 32 + fq * 8)); \
            dst##8[n] = __builtin_shufflevector(lo_, hi_, 0, 1, 2, 3, 4, 5, 6, 7); } } \
        else { _Pragma("unroll") for (int n = 0; n < 2; ++n) _Pragma("unroll") for (int k = 0; k < 2; ++k) \
            dst[n][k] = *reinterpret_cast<const bf16x8*>(G_SB(b, h) + lds_byte(wc * 32 + n * 16 + fr, k * 32 + fq * 8)); } } while (0)
#define G_MMA(ai, bj, At_, Bt_) do { __builtin_amdgcn_s_setprio(1); \
        if (F8) { _Pragma("unroll") for (int m = 0; m < 4; ++m) _Pragma("unroll") for (int n = 0; n < 2; ++n) \
                asm volatile("v_mfma_scale_f32_16x16x128_f8f6f4 %0, %1, %2, %0, %3, %4 op_sel_hi:[0,0,0]" : "+v"(acc[ai][bj][m][n]) : "v"(Bt_##8[n]), "v"(At_##8[m]), "v"(f8sw), "v"(f8sa)); } \
        else { _Pragma("unroll") for (int m = 0; m < 4; ++m) _Pragma("unroll") for (int n = 0; n < 2; ++n) _Pragma("unroll") for (int k = 0; k < 2; ++k) \
            acc[ai][bj][m][n] = __builtin_amdgcn_mfma_f32_16x16x32_bf16(Bt_[n][k], At_[m][k], acc[ai][bj][m][n], 0, 0, 0); } \
        __builtin_amdgcn_s_setprio(0); } while (0)
#define G_WAIT_V(n) asm volatile("s_waitcnt vmcnt(" #n ")" ::: "memory")
#define G_WAIT_L(n) asm volatile("s_waitcnt lgkmcnt(" #n ")" ::: "memory")
#define G_BAR __builtin_amdgcn_s_barrier()
#define G_SCHED __builtin_amdgcn_sched_barrier(0)
    int t0 = threadIdx.x; asm volatile("" : "+v"(t0));
    const __amdgpu_buffer_rsrc_t rsrcA = __builtin_amdgcn_make_buffer_rsrc((void*)A, 0, -1, 0x00020000), rsrcB = __builtin_amdgcn_make_buffer_rsrc((void*)Bt, 0, -1, 0x00020000);
    int wid = t0 >> 6, lane = t0 & 63, wr = wid >> 2, wc = wid & 3, fr = lane & 15, fq = lane >> 4;
    f32x4 acc[2][2][4][2] = {};
    init(acc, wr, wc, fr, fq);
    bf16x8 At[4][2], B0[2][2], B1[2][2];
    i32x8 At8[4], B08[2], B18[2];
    const int f8sw = F8_SCALE_W, f8sa = F8_SCALE_A;
    const int nt = K / G_BK;
    G_STAGE_B(t0, G_SB(0, 0), 0, 0); G_STAGE_A(t0, G_SA(0, 0), 0, 0);
    G_STAGE_B(t0, G_SB(0, 1), 1, 0); G_STAGE_A(t0, G_SA(0, 1), 1, 0);
    if (wr == 1) G_BAR;
    G_WAIT_V(4); G_BAR;
    G_STAGE_B(t0, G_SB(1, 0), 0, 1); G_STAGE_A(t0, G_SA(1, 0), 0, 1); G_STAGE_B(t0, G_SB(1, 1), 1, 1);
    G_WAIT_V(6); G_BAR;
    for (int t = 0; t < nt - 2; t += 2) {
        G_LDB(B0, 0, 0); G_SCHED; G_LDA(At, 0, 0); G_STAGE_A(t0, G_SA(1, 1), 1, t + 1);
        G_WAIT_L(8); G_BAR; G_WAIT_L(0); G_MMA(0, 0, At, B0); G_BAR; G_SCHED;
        G_LDB(B1, 0, 1); G_STAGE_B(t0, G_SB(0, 0), 0, t + 2);
        G_BAR; G_WAIT_L(0); G_MMA(0, 1, At, B1); G_BAR;
        G_LDA(At, 0, 1); G_STAGE_A(t0, G_SA(0, 0), 0, t + 2);
        G_BAR; G_WAIT_L(0); G_MMA(1, 0, At, B0); G_BAR; G_SCHED;
        G_STAGE_B(t0, G_SB(0, 1), 1, t + 2);
        G_WAIT_V(6); G_BAR; G_MMA(1, 1, At, B1); G_BAR;
        G_LDB(B0, 1, 0); G_SCHED; G_LDA(At, 1, 0); G_STAGE_A(t0, G_SA(0, 1), 1, t + 2);
        G_WAIT_L(8); G_BAR; G_WAIT_L(0); G_MMA(0, 0, At, B0); G_BAR; G_SCHED;
        G_LDB(B1, 1, 1); G_STAGE_B(t0, G_SB(1, 0), 0, t + 3);
        G_BAR; G_WAIT_L(0); G_MMA(0, 1, At, B1); G_BAR;
        G_LDA(At, 1, 1); G_STAGE_A(t0, G_SA(1, 0), 0, t + 3);
        G_BAR; G_WAIT_L(0); G_MMA(1, 0, At, B0); G_BAR; G_SCHED;
        G_STAGE_B(t0, G_SB(1, 1), 1, t + 3);
        G_WAIT_V(6); G_BAR; G_MMA(1, 1, At, B1); G_BAR;
    }
    int tz = threadIdx.x; asm volatile("" : "+v"(tz)); wid = tz >> 6; lane = tz & 63; wr = wid >> 2; wc = wid & 3; fr = lane & 15; fq = lane >> 4;
    { G_LDB(B0, 0, 0); G_WAIT_V(0); G_LDA(At, 0, 0); G_STAGE_A(tz, G_SA(1, 1), 1, nt - 1);
      G_BAR; G_WAIT_L(0); G_MMA(0, 0, At, B0); G_BAR;
      G_LDB(B1, 0, 1); G_BAR; G_WAIT_L(0); G_MMA(0, 1, At, B1); G_BAR;
      G_LDA(At, 0, 1); G_WAIT_V(4); G_BAR; G_WAIT_L(0); G_MMA(1, 0, At, B0); G_MMA(1, 1, At, B1); G_BAR; }
    { G_LDB(B0, 1, 0); G_LDA(At, 1, 0); G_WAIT_V(2); G_BAR; G_WAIT_L(0); G_MMA(0, 0, At, B0); G_BAR;
      G_LDB(B1, 1, 1); G_WAIT_V(0); G_BAR; G_WAIT_L(0); G_MMA(0, 1, At, B1); G_BAR;
      G_LDA(At, 1, 1); G_BAR; G_WAIT_L(0); G_MMA(1, 0, At, B0); G_MMA(1, 1, At, B1); G_BAR; }
    if (wr == 0) G_BAR;
    if (F8) asm volatile("s_nop 7\n\ts_nop 7\n\ts_nop 7" ::: "memory");
    epi(acc, wr, wc, fr, fq);
#undef G_SA
#undef G_SB
#undef G_STAGE_A
#undef G_STAGE_B
#undef G_LDA
#undef G_LDB
#undef G_MMA
#undef G_WAIT_V
#undef G_WAIT_L
#undef G_BAR
#undef G_SCHED
}

template <class Fn>
__device__ __forceinline__ void for_units(int nMt, int nNt, Fn fn) {
    const int nMg = (nMt + 3) >> 2, nNg = (nNt + 7) >> 3, ngroups = nMg * nNg;
    const int xcd = blockIdx.x & 7, local = blockIdx.x >> 3, nlocal = gridDim.x >> 3;
    for (int g = xcd; g < ngroups; g += 8) {
        const int mg = g / nNg, ng = g % nNg;
        for (int l = local; l < 32; l += nlocal) {
            const int mt = mg * 4 + (l & 3), nt = ng * 8 + (l >> 2);
            if (mt < nMt && nt < nNt) fn(mt, nt);
        }
    }
}

constexpr int LDS_RED_OFF = 131072 + 128;
__device__ __forceinline__ const float* head_norm_w(const P& p, int cb) {
    return cb < 8 ? p.nsa_q_norm : (cb == 12 || cb == 13) ? p.nsa_k_norm + DH : (cb == 16 || cb == 17) ? p.nsa_k_norm + 2 * DH : (cb >= 20 && cb < 28) ? p.fox_q_norm : (cb >= 28 && cb < 36) ? p.fox_k_norm : nullptr;
}
template <bool F8>
__device__ __forceinline__ void inproj_unit(const P& p, char* shm, int mt, int nt) {
    bf16_t* C = p.projb;
    float* red = (float*)(shm + LDS_RED_OFF);
    {
        const bf16_t* At = (const bf16_t*)(p.hq + (size_t)mt * 256 * D);
        const float* gw0 = head_norm_w(p, nt * 2), * gw1 = head_norm_w(p, nt * 2 + 1);
        auto epi = [=](const f32x4 (&acc)[2][2][4][2], int wr, int wc, int fr, int fq) {
                    if (gw0 || gw1) {
#pragma unroll
                        for (int ai = 0; ai < 2; ++ai)
#pragma unroll
                            for (int m = 0; m < 4; ++m)
#pragma unroll
                                for (int bj = 0; bj < 2; ++bj) {
                                    const f32x4 a = acc[ai][bj][m][0], b = acc[ai][bj][m][1];
                                    float ss = (a[0] * a[0] + a[1] * a[1]) + (a[2] * a[2] + a[3] * a[3]) + (b[0] * b[0] + b[1] * b[1]) + (b[2] * b[2] + b[3] * b[3]);
                                    ss += __shfl_xor(ss, 16); ss += __shfl_xor(ss, 32);
                                    if (fq == 0) red[((ai * 128 + wr * 64 + m * 16 + fr) * 2 + bj) * 4 + wc] = ss;
                                }
                        __syncthreads();
                    }
#pragma unroll
                    for (int ai = 0; ai < 2; ++ai)
#pragma unroll
                        for (int m = 0; m < 4; ++m) {
                            const int rl = ai * 128 + wr * 64 + m * 16 + fr, t = mt * 256 + rl;
                            bf16_t* rowp = C + (size_t)t * IN_PAD + nt * 256 + wc * 32 + fq * 4;
#pragma unroll
                            for (int bj = 0; bj < 2; ++bj) {
                                const int cb = nt * 2 + bj;
                                if (cb == 45) continue;
                                if (cb == 44) {
                                    if (wc == 0) {
#pragma unroll
                                        for (int n = 0; n < 2; ++n)
#pragma unroll
                                            for (int jx = 0; jx < 4; ++jx) {
                                                const int c = n * 16 + fq * 4 + jx; const float v = acc[ai][bj][m][n][jx];
                                                if (c < 24) p.gatesf[(size_t)t * 24 + c] = 1.f / (1.f + __expf(-(v + p.b_nsa_gate[c])));
                                                else p.logf[(size_t)t * 8 + (c - 24)] = log_sigmoid(v + p.fox_forget_bias[c - 24]);
                                            }
                                    }
                                    continue;
                                }
                                const float* gw = bj ? gw1 : gw0;
                                float rs = 1.f;
                                if (gw) { const f32x4 pr = *(const f32x4*)(red + (rl * 2 + bj) * 4); rs = rsqrtf(((pr[0] + pr[1]) + (pr[2] + pr[3])) / DH + EPS); }
#pragma unroll
                                for (int n = 0; n < 2; ++n) {
                                    f32x4 v = acc[ai][bj][m][n] * rs;
                                    if (gw) v = v * *(const f32x4*)(gw + wc * 32 + n * 16 + fq * 4);
                                    u32x2 w; w.x = cvt_pk_bf16(v[0], v[1]); w.y = cvt_pk_bf16(v[2], v[3]);
                                    *(u32x2*)(rowp + bj * 128 + n * 16) = w;
                                }
                            }
                        }
                };
        if (F8) gemm256<true>(At, [](int r) { return r * (D / 2); }, [](int kt) { return kt * G_BK; }, (const bf16_t*)(p.winq + (size_t)nt * 256 * D), D / 2, D / 2, shm, epi);
        else gemm256<false>(p.hb + (size_t)mt * 256 * D, [](int r) { return r * D; }, [](int kt) { return kt * G_BK; }, p.winT + (size_t)nt * 256 * D, D, D, shm, epi);
    }
}
__device__ __forceinline__ void ph_inproj_fast(const P& p, char* shm) {
    const int xcd = blockIdx.x & 7, local = blockIdx.x >> 3, nlocal = gridDim.x >> 3;
    for (int mg = xcd; mg < T / 1024; mg += 8) {
        for (int l = local; l < 32; l += nlocal) {
            const int j = l >> 2, nt = j < 3 ? 5 + 2 * j : j < 7 ? 15 + j : 22;
            inproj_unit<false>(p, shm, mg * 4 + (l & 3), nt);
        }
        for (int l = local; l < 60; l += nlocal) {
            const int k = l >> 2, nt = k < 5 ? k : k == 5 ? 6 : k == 6 ? 8 : k + 3;
            inproj_unit<true>(p, shm, mg * 4 + (l & 3), nt);
        }
    }
}

__device__ __forceinline__ void ph_outproj_fast(const P& p, char* shm) {
    const bf16_t* A = p.mixb; bf16_t* C = p.x1; const float* X = p.x; const float* mod = p.mod;
    for_units(T / 256, D / 256, [&](int mt, int nt) {
        const bf16_t* At = A + (size_t)mt * 256 * D;
        const float* ga = mod + (size_t)((mt * 256) / S) * 6 * D + 2 * D;
        gemm256<false>(At, [](int r) { return r * D; }, [](int kt) { return kt * G_BK; }, p.woutT + (size_t)nt * 256 * D, D, D, shm,
                [=](const f32x4 (&acc)[2][2][4][2], int wr, int wc, int fr, int fq) {
#pragma unroll
                    for (int ai = 0; ai < 2; ++ai)
#pragma unroll
                        for (int m = 0; m < 4; ++m) {
                            const size_t ro = (size_t)(mt * 256 + ai * 128 + wr * 64 + m * 16 + fr) * D;
#pragma unroll
                            for (int bj = 0; bj < 2; ++bj)
#pragma unroll
                                for (int n = 0; n < 2; ++n) {
                                    const int col = nt * 256 + bj * 128 + wc * 32 + n * 16 + fq * 4;
                                    const f32x4 xv = *(const f32x4*)(X + ro + col), gv = *(const f32x4*)(ga + col);
                                    const f32x4 r = xv + gv * acc[ai][bj][m][n];
                                    u32x2 w; w.x = cvt_pk_bf16(r[0], r[1]); w.y = cvt_pk_bf16(r[2], r[3]);
                                    *(u32x2*)(C + ro + col) = w;
                                }
                        }
                });
    });
}

constexpr int CAP = T;
__device__ __forceinline__ void ph_router_fast(const P& p, char* ldsc) {
    unsigned char* h2t = (unsigned char*)ldsc;
    float* rs_l = (float*)(ldsc + 65536);
    char* hsb = ldsc + 65792;
    float* part = (float*)hsb;
    float* logit = (float*)(hsb + 32768);
    int* destl = (int*)(hsb + 32768 + 32 * 33 * 4);
    int* hist = destl + 128;
    int tid = threadIdx.x; asm volatile("" : "+v"(tid));
    const int w = tid >> 6, lane = tid & 63;
    for (int blk = blockIdx.x; blk < T / 32; blk += gridDim.x) {
        const int t0 = blk * 32, b = t0 / S;
        __syncthreads();
#pragma unroll
        for (int q = 0; q < 4; ++q) {
            const bf16_t* xr = p.x1 + (size_t)(t0 + w * 4 + q) * D;
            float ss = 0.f;
#pragma unroll
            for (int i = 0; i < 8; ++i) { const f32x4 v = bf16x4_f(*(const u32x2*)(xr + (i * 64 + lane) * 4)); ss += v[0] * v[0] + v[1] * v[1] + v[2] * v[2] + v[3] * v[3]; }
            ss = wave_sum(ss);
            if (lane == 0) rs_l[w * 4 + q] = rsqrtf(ss / D + EPS);
        }
        __syncthreads();
        {
            const int i = lane & 31, hlf = lane >> 5;
            float* hs = (float*)hsb + w * (64 * 36);
            const int lr = lane >> 3, lc = (lane & 7) * 4;
            const float* rw = p.router_w + (size_t)(w * 256 + hlf * 128) * NE + i;
            f32x16 acc = {};
            f32x4 xv[8];
#define R_LOAD(ch_) do { _Pragma("unroll") for (int jj = 0; jj < 8; ++jj) { const int row = lr + 8 * jj; \
                xv[jj] = bf16x4_f(*(const u32x2*)(p.x1 + (size_t)(t0 + (row & 31)) * D + w * 256 + (row >> 5) * 128 + (ch_) * 32 + lc)); } } while (0)
            R_LOAD(0);
#pragma unroll 1
            for (int ch = 0; ch < 4; ++ch) {
#pragma unroll
                for (int jj = 0; jj < 8; ++jj) {
                    const int row = lr + 8 * jj, tok = row & 31, kk = w * 256 + (row >> 5) * 128 + ch * 32 + lc;
                    const float rsi = rs_l[tok];
                    const f32x4 gv = *(const f32x4*)(p.norm_moe + kk), sv = *(const f32x4*)(p.mod + (size_t)b * 6 * D + 4 * D + kk), hv = *(const f32x4*)(p.mod + (size_t)b * 6 * D + 3 * D + kk);
                    f32x4 h;
#pragma unroll
                    for (int c = 0; c < 4; ++c) h[c] = xv[jj][c] * rsi * gv[c] * (1.f + sv[c]) + hv[c];
                    *(unsigned*)(h2t + tok * D + kk) = pack4_fp8(h[0], h[1], h[2], h[3]);
                    *(f32x4*)(hs + row * 36 + lc) = h;
                }
                if (ch < 3) R_LOAD(ch + 1);
#pragma unroll
                for (int q = 0; q < 8; ++q) {
                    const f32x4 h = *(const f32x4*)(hs + (hlf * 32 + i) * 36 + q * 4);
#pragma unroll
                    for (int c = 0; c < 4; ++c) acc = __builtin_amdgcn_mfma_f32_32x32x2f32(h[c], rw[(size_t)(ch * 32 + q * 4 + c) * NE], acc, 0, 0, 0);
                }
            }
#undef R_LOAD
            __syncthreads();
            const int hi = lane >> 5;
#pragma unroll
            for (int r = 0; r < 16; ++r) part[(w * 32 + ((r & 3) + 8 * (r >> 2) + 4 * hi)) * 32 + i] = acc[r];
        }
        __syncthreads();
#pragma unroll
        for (int j = 0; j < 2; ++j) {
            const int e2 = tid + j * 512, tok = e2 >> 5, e = e2 & 31;
            float s = p.router_b[e];
#pragma unroll
            for (int ww = 0; ww < 8; ++ww) s += part[(ww * 32 + tok) * 32 + e];
            logit[tok * 33 + e] = s;
        }
        __syncthreads();
        if (tid < 32) {
            float lv[32];
#pragma unroll
            for (int e = 0; e < 32; ++e) lv[e] = logit[tid * 33 + e];
            int ti[4]; float tv[4];
#pragma unroll
            for (int k = 0; k < 4; ++k) {
                float bv = lv[0]; int bi = 0;
#pragma unroll
                for (int e = 1; e < 32; ++e) if (lv[e] > bv) { bv = lv[e]; bi = e; }
                ti[k] = bi; tv[k] = bv;
#pragma unroll
                for (int e = 0; e < 32; ++e) lv[e] = (e == bi) ? -3.4e38f : lv[e];
            }
            float ex[4], den = 0.f;
#pragma unroll
            for (int k = 0; k < 4; ++k) { ex[k] = __expf(tv[k] - tv[0]); den += ex[k]; }
            const float inv = 1.f / den;
            int lrank[4];
            hist[tid] = 0;
#pragma unroll
            for (int k = 0; k < 4; ++k) lrank[k] = atomicAdd(&hist[ti[k]], 1);
            const int mine = hist[tid];
            hist[32 + tid] = mine > 0 ? atomicAdd(p.cnt + tid * 64, mine) : 0;
#pragma unroll
            for (int k = 0; k < 4; ++k) {
                const int d = ti[k] * CAP + hist[32 + ti[k]] + lrank[k];
                destl[tid * 4 + k] = d;
                p.row_a[d] = (t0 + tid) * 4 + k; p.row_w[d] = ex[k] * inv;
            }
        }
        __syncthreads();
#pragma unroll 4
        for (int a = w; a < 128; a += 8) {
            const unsigned char* src = h2t + (a >> 2) * D;
            unsigned char* dst = p.xgq + (size_t)destl[a] * D;
#pragma unroll
            for (int jj = 0; jj < 2; ++jj) *(u32x4*)(dst + (jj * 64 + lane) * 16) = *(const u32x4*)(src + (jj * 64 + lane) * 16);
        }
    }
}

constexpr int MAXTILES = 160;
constexpr int LDS_TILE_TAB = 131072 + 64;
__device__ __forceinline__ int build_tile_table(const P& p, char* shm) {
    int* tab = (int*)(shm + LDS_TILE_TAB);
    int* cs = (int*)(shm + LDS_TILE_TAB + 1024);
    int tid = threadIdx.x; asm volatile("" : "+v"(tid));
    __syncthreads();
    int nt = 0;
    if (tid < NE) { nt = (p.cnt[tid * 64] + 255) >> 8; cs[tid] = nt; }
    __syncthreads();
    if (tid < NE) {
        int base = 0;
#pragma unroll
        for (int e = 0; e < NE; ++e) base += e < tid ? cs[e] : 0;
        for (int jt = 0; jt < nt; ++jt) tab[1 + base + jt] = (tid << 8) | jt;
        if (tid == NE - 1) tab[0] = base + nt;
    }
    __syncthreads();
    return __builtin_amdgcn_readfirstlane(tab[0]);
}

__device__ __forceinline__ void ph_up_fast(const P& p, char* shm) {
    const int ntiles = build_tile_table(p, shm);
    const int* tab = (const int*)(shm + LDS_TILE_TAB) + 1;
    for_units(ntiles, 16, [&](int mt, int nt) {
        const int te = __builtin_amdgcn_readfirstlane(tab[mt]), e = te >> 8;
        const size_t row0 = (size_t)e * CAP + (size_t)(te & 255) * 256;
        const bf16_t* At = (const bf16_t*)(p.xgq + row0 * D);
        const float* bu = p.b_up + (size_t)e * 2 * F + nt * 128;
        unsigned char* C = p.actq + row0 * F + nt * 128;
        gemm256<true>(At, [](int r) { return r * (D / 2); }, [](int kt) { return kt * G_BK; }, (const bf16_t*)(p.wupq + ((size_t)e * 2 * F + (size_t)nt * 256) * D), D / 2, D / 2, shm,
                [=](const f32x4 (&acc)[2][2][4][2], int wr, int wc, int fr, int fq) {
                    const int col = wc * 32 + fq * 8;
#pragma unroll
                    for (int ai = 0; ai < 2; ++ai)
#pragma unroll
                        for (int m = 0; m < 4; ++m) {
                            float o[8];
#pragma unroll
                            for (int n = 0; n < 2; ++n) {
                                const f32x4 g4 = acc[ai][0][m][n], l4 = acc[ai][1][m][n];
#pragma unroll
                                for (int j = 0; j < 4; ++j) {
                                    const float gl = fminf(g4[j], 7.f), li = fminf(fmaxf(l4[j], -7.f), 7.f);
                                    o[n * 4 + j] = gl * __builtin_amdgcn_rcpf(1.f + __expf(-1.702f * gl)) * (li + 1.f);
                                }
                            }
                            u32x2 wv; wv.x = pack4_fp8(o[0], o[1], o[2], o[3]); wv.y = pack4_fp8(o[4], o[5], o[6], o[7]);
                            *(u32x2*)(C + (size_t)(ai * 128 + wr * 64 + m * 16 + fr) * F + col) = wv;
                        }
                },
                [=](f32x4 (&acc)[2][2][4][2], int, int wc, int, int fq) {
                    const int col = wc * 32 + fq * 8;
#pragma unroll
                    for (int n = 0; n < 2; ++n) {
                        const f32x4 bg = *(const f32x4*)(bu + col + 4 * n), bl = *(const f32x4*)(bu + F + col + 4 * n);
#pragma unroll
                        for (int ai = 0; ai < 2; ++ai)
#pragma unroll
                            for (int m = 0; m < 4; ++m) { acc[ai][0][m][n] = bg; acc[ai][1][m][n] = bl; }
                    }
                });
    });
}

__device__ __forceinline__ void ph_down_fast(const P& p, char* shm) {
    const int ntiles = __builtin_amdgcn_readfirstlane(*(const int*)(shm + LDS_TILE_TAB));
    const int* tab = (const int*)(shm + LDS_TILE_TAB) + 1;
    for_units(ntiles, 8, [&](int mt, int nt) {
        const int te = __builtin_amdgcn_readfirstlane(tab[mt]), e = te >> 8;
        const size_t row0 = (size_t)e * CAP + (size_t)(te & 255) * 256;
        const int nvalid = p.cnt[e * 64] - (te & 255) * 256;
        const bf16_t* At = (const bf16_t*)(p.actq + row0 * F);
        const float* bd = p.b_down + (size_t)e * D + nt * 256;
        const int* ra = p.row_a + row0; const float* rwt = p.row_w + row0;
        unsigned char* Y = p.yq + nt * 256;
        gemm256<true>(At, [](int r) { return r * (F / 2); }, [](int kt) { return kt * G_BK; }, (const bf16_t*)(p.wdnq + ((size_t)e * D + (size_t)nt * 256) * F), F / 2, F / 2, shm,
                [=](const f32x4 (&acc)[2][2][4][2], int wr, int wc, int fr, int fq) {
#pragma unroll
                    for (int ai = 0; ai < 2; ++ai)
#pragma unroll
                        for (int m = 0; m < 4; ++m) {
                            const int row = ai * 128 + wr * 64 + m * 16 + fr;
                            if (row < nvalid) {
                                const int a = ra[row];
                                const float wgt = rwt[row];
                                unsigned char* yr = Y + (size_t)a * D;
#pragma unroll
                                for (int bj = 0; bj < 2; ++bj) {
                                    const int col = bj * 128 + wc * 32 + fq * 8;
                                    const f32x4 v0 = acc[ai][bj][m][0] * wgt, v1 = acc[ai][bj][m][1] * wgt;
                                    f32x4 s0 = v0 * 16.f, s1 = v1 * 16.f;
#pragma unroll
                                    for (int j = 0; j < 4; ++j) { s0[j] = __builtin_amdgcn_fmed3f(s0[j], -448.f, 448.f); s1[j] = __builtin_amdgcn_fmed3f(s1[j], -448.f, 448.f); }
                                    u32x2 wv; wv.x = pack4_fp8(s0[0], s0[1], s0[2], s0[3]); wv.y = pack4_fp8(s1[0], s1[1], s1[2], s1[3]);
                                    *(u32x2*)(yr + col) = wv;
                                }
                            }
                        }
                },
                [=](f32x4 (&acc)[2][2][4][2], int, int wc, int, int fq) {
#pragma unroll
                    for (int bj = 0; bj < 2; ++bj)
#pragma unroll
                        for (int n = 0; n < 2; ++n) {
                            const f32x4 b = *(const f32x4*)(bd + bj * 128 + wc * 32 + fq * 8 + 4 * n);
#pragma unroll
                            for (int ai = 0; ai < 2; ++ai)
#pragma unroll
                                for (int m = 0; m < 4; ++m) acc[ai][bj][m][n] = b;
                        }
                });
    });
}

__device__ __forceinline__ void ph_final_fast(const P& p) {
    constexpr size_t NV = (size_t)T * D / 4;
    const size_t stride = (size_t)gridDim.x * NTHR;
    int tid = threadIdx.x; asm volatile("" : "+v"(tid));
    for (size_t i0 = (size_t)blockIdx.x * NTHR + tid; i0 < NV; i0 += 4 * stride) {
        unsigned yv[4][4]; f32x4 xv[4], gm[4];
#pragma unroll
        for (int u = 0; u < 4; ++u) {
            size_t i = i0 + u * stride; i = i < NV ? i : NV - 1;
            const size_t t = i / (D / 4); const int n = (int)(i % (D / 4)) * 4;
#pragma unroll
            for (int k = 0; k < 4; ++k) yv[u][k] = *(const unsigned*)(p.yq + (t * 4 + k) * D + n);
            xv[u] = bf16x4_f(*(const u32x2*)(p.x1 + t * D + n));
            gm[u] = *(const f32x4*)(p.mod + (t / S) * 6 * D + 5 * D + n);
        }
#pragma unroll
        for (int u = 0; u < 4; ++u) {
            const size_t i = i0 + u * stride;
            f32x4 s = {0.f, 0.f, 0.f, 0.f};
#pragma unroll
            for (int k = 0; k < 4; ++k) { const f32x2 lo = __builtin_amdgcn_cvt_pk_f32_fp8((int)yv[u][k], false), hi = __builtin_amdgcn_cvt_pk_f32_fp8((int)yv[u][k], true); s[0] += lo[0]; s[1] += lo[1]; s[2] += hi[0]; s[3] += hi[1]; }
            if (i < NV) *(f32x4*)(p.out + i * 4) = xv[u] + gm[u] * s * 0.0625f;
        }
    }
}

typedef short s16x4 __attribute__((ext_vector_type(4)));
constexpr int A_SHM = 64 * 128 * 2;
constexpr int A_OFF_V = 0, A_OFF_K = 2 * A_SHM, A_OFF_WS = 4 * A_SHM, A_OFF_TBL = A_OFF_WS + 8 * 64 * 4, A_OFF_CK = A_OFF_TBL + 8 * 128 * 4, A_OFF_Q = A_OFF_CK + 2 * 64 * 4, A_OFF_SEL = A_OFF_Q + 256, A_OFF_CUM = A_OFF_SEL + 256;
constexpr float LOG2E = 1.4426950408889634f;
#define A_KSWZ(row, colB) ((row) * 256 + ((colB) ^ (((row) & 7) << 4)))
__device__ __forceinline__ int a_v_st(int k, int c) { const int kk = (k & ~0xC) | ((k & 4) << 1) | ((k & 8) >> 1); return ((kk >> 3) * 4 + (c >> 5)) * 512 + ((kk & 7) * 32 + (c & 31)) * 2; }
__device__ __forceinline__ int a_v_rd_base(int lane) { return ((lane & 3) << 3) | (((lane >> 2) & 3) << 6) | (((lane >> 4) & 1) << 5) | (((lane >> 5) & 1) << 8); }
__device__ __forceinline__ int a_crow(int r, int hi) { return (r & 3) + 8 * (r >> 2) + 4 * hi; }

__device__ __forceinline__ void a_qkt(f32x16& p0, f32x16& p1, const char* kbase, int r32, int hi, const bf16x8* qr) {
    p0 = f32x16{}; p1 = f32x16{};
    const char* kb[4];
#pragma unroll
    for (int dd = 0; dd < 4; ++dd) kb[dd] = kbase + A_KSWZ(r32, (dd * 16 + hi * 8) * 2);
#pragma unroll
    for (int d0 = 0; d0 < 8; ++d0) {
        const char* a = kb[d0 & 3] + (d0 >> 2) * 128;
        const bf16x8 b0 = *reinterpret_cast<const bf16x8*>(a);
        const bf16x8 b1 = *reinterpret_cast<const bf16x8*>(a + 32 * 256);
        p0 = __builtin_amdgcn_mfma_f32_32x32x16_bf16(b0, qr[d0], p0, 0, 0, 0);
        p1 = __builtin_amdgcn_mfma_f32_32x32x16_bf16(b1, qr[d0], p1, 0, 0, 0);
    }
}
__device__ __forceinline__ void a_pv(f32x16* o, int vb, bf16x8 pa0, bf16x8 pa1, bf16x8 pa2, bf16x8 pa3) {
#define A_TRRD(dst, off) asm volatile("ds_read_b64_tr_b16 %0, %1 offset:%2" : "=&v"(dst) : "v"(vb), "i"(off) : "memory")
#define A_RD8(S_, d0) do { constexpr int b_ = (d0) * 512; \
        A_TRRD(S_##l0, b_); A_TRRD(S_##h0, b_ + 2048); A_TRRD(S_##l1, b_ + 4096); A_TRRD(S_##h1, b_ + 6144); A_TRRD(S_##l2, b_ + 8192); A_TRRD(S_##h2, b_ + 10240); A_TRRD(S_##l3, b_ + 12288); A_TRRD(S_##h3, b_ + 14336); } while (0)
#define A_MM4(S_, d0) do { \
        o[d0] = __builtin_amdgcn_mfma_f32_32x32x16_bf16(pa0, (bf16x8){S_##l0[0], S_##l0[1], S_##l0[2], S_##l0[3], S_##h0[0], S_##h0[1], S_##h0[2], S_##h0[3]}, o[d0], 0, 0, 0); \
        o[d0] = __builtin_amdgcn_mfma_f32_32x32x16_bf16(pa1, (bf16x8){S_##l1[0], S_##l1[1], S_##l1[2], S_##l1[3], S_##h1[0], S_##h1[1], S_##h1[2], S_##h1[3]}, o[d0], 0, 0, 0); \
        o[d0] = __builtin_amdgcn_mfma_f32_32x32x16_bf16(pa2, (bf16x8){S_##l2[0], S_##l2[1], S_##l2[2], S_##l2[3], S_##h2[0], S_##h2[1], S_##h2[2], S_##h2[3]}, o[d0], 0, 0, 0); \
        o[d0] = __builtin_amdgcn_mfma_f32_32x32x16_bf16(pa3, (bf16x8){S_##l3[0], S_##l3[1], S_##l3[2], S_##l3[3], S_##h3[0], S_##h3[1], S_##h3[2], S_##h3[3]}, o[d0], 0, 0, 0); } while (0)
    s16x4 xl0, xl1, xl2, xl3, xh0, xh1, xh2, xh3, yl0, yl1, yl2, yl3, yh0, yh1, yh2, yh3;
    A_RD8(x, 0);
    A_RD8(y, 1);
    asm volatile("s_waitcnt lgkmcnt(8)" ::: "memory"); __builtin_amdgcn_sched_barrier(0);
    A_MM4(x, 0);
    __builtin_amdgcn_sched_barrier(0);
    A_RD8(x, 2);
    asm volatile("s_waitcnt lgkmcnt(8)" ::: "memory"); __builtin_amdgcn_sched_barrier(0);
    A_MM4(y, 1);
    __builtin_amdgcn_sched_barrier(0);
    A_RD8(y, 3);
    asm volatile("s_waitcnt lgkmcnt(8)" ::: "memory"); __builtin_amdgcn_sched_barrier(0);
    A_MM4(x, 2);
    asm volatile("s_waitcnt lgkmcnt(0)" ::: "memory"); __builtin_amdgcn_sched_barrier(0);
    A_MM4(y, 3);
#undef A_MM4
#undef A_RD8
#undef A_TRRD
}

__device__ __forceinline__ void a_build_tbl(const P& p, char* lds) {
    float* tbl = (float*)(lds + A_OFF_TBL);
    for (int i = threadIdx.x; i < 8 * 128; i += NTHR) { const int h = i >> 7, d = i & 127; tbl[i] = p.rel_bias[BUCKET[d] * 8 + h] * LOG2E; }
}

template <int MODE>
__device__ __forceinline__ void attn_unit(const P& p, int b, int hh, int qb, char* lds) {
    int tid = threadIdx.x; asm volatile("" : "+v"(tid));
    const int wid = __builtin_amdgcn_readfirstlane(tid >> 6), lane = tid & 63, r32 = lane & 31, hi = lane >> 5;
    int h, q0, qlo, qoff, koff, voff, j_lo, j_hi;
    if (MODE == 2) { h = hh; q0 = qb * 256; qlo = q0 + 32 * wid; qoff = OFF_QF + h * DH; koff = OFF_KF + h * DH; voff = OFF_VF + h * DH; j_lo = 0; j_hi = 4 * qb + 4; }
    else { h = hh * R + (wid >> 1); q0 = qb * 64; qlo = q0 + 32 * (wid & 1); qoff = OFF_QN + h * DH;
           koff = (MODE == 0 ? OFF_KW : OFF_KS) + hh * DH; voff = (MODE == 0 ? OFF_VW : OFF_VS) + hh * DH;
           j_lo = (MODE == 0 && q0 > 511) ? ((q0 - 511) >> 6) : 0; j_hi = qb + 1; }
    const int NT = j_hi - j_lo;
    const bf16_t* base = p.projb + (size_t)b * S * IN_PAD;
    char* V_lds = lds + A_OFF_V; char* K_lds = lds + A_OFF_K;
    float* ws = (float*)(lds + A_OFF_WS) + wid * 64; float* li_l = ws; float* al_l = ws + 32;
    const float* tbl = (const float*)(lds + A_OFF_TBL) + h * 128;
    float* cum_l = (float*)(lds + A_OFF_CUM);
    bf16x8 qr[8];
    {
        const bf16_t* qrow = base + (size_t)(qlo + r32) * IN_PAD + qoff + hi * 8;
#pragma unroll
        for (int d0 = 0; d0 < 8; ++d0) qr[d0] = *reinterpret_cast<const bf16x8*>(qrow + d0 * 16);
    }
    unsigned selm = 0xffffffffu;
    const float c31 = (MODE == 2) ? 0.f : tbl[127];
    constexpr float C2 = LOG2E * SCALE;
    constexpr float THR2 = 8.f * LOG2E;
    constexpr unsigned WMASK = MODE == 0 ? 512u : 0x80000000u;
    const int sr = tid >> 4, sc = (tid & 15) * 8;
    const int kws = A_KSWZ(sr, sc * 2), vst0 = a_v_st(sr, sc), vst1 = a_v_st(32 + sr, sc);
    const int vb0 = (int)(uintptr_t)V_lds + a_v_rd_base(lane);
    float m_reg = -1e30f, l_reg = 0.f; f32x16 o[4] = {};
    bf16x8 st_k0, st_k1, st_v0, st_v1;
#define A_LOAD(kb_) do { const bf16_t* r0_ = base + (size_t)((kb_) + sr) * IN_PAD + sc; const bf16_t* r1_ = r0_ + (size_t)32 * IN_PAD; \
        st_k0 = *reinterpret_cast<const bf16x8*>(r0_ + koff); st_k1 = *reinterpret_cast<const bf16x8*>(r1_ + koff); \
        st_v0 = *reinterpret_cast<const bf16x8*>(r0_ + voff); st_v1 = *reinterpret_cast<const bf16x8*>(r1_ + voff); \
        } while (0)
#define A_WRITE(bf_) do { *(bf16x8*)(K_lds + (bf_) * A_SHM + kws) = st_k0; *(bf16x8*)(K_lds + (bf_) * A_SHM + kws + 32 * 256) = st_k1; \
        *(bf16x8*)(V_lds + (bf_) * A_SHM + vst0) = st_v0; *(bf16x8*)(V_lds + (bf_) * A_SHM + vst1) = st_v1; \
        } while (0)
    __syncthreads();
    A_LOAD(j_lo * 64);
    float v4[4] = {0.f, 0.f, 0.f, 0.f};
    if (MODE == 2) {
        const int nkeys = q0 + 256;
        const float* lf = p.logf + (size_t)b * S * 8 + h;
#pragma unroll
        for (int i = 0; i < 4; ++i) { const int sidx = tid * 4 + i; v4[i] = sidx < nkeys ? lf[(size_t)sidx * 8] : 0.f; }
    }
    A_WRITE(0);
    if (MODE == 2) {
        float run = 0.f;
#pragma unroll
        for (int i = 0; i < 4; ++i) { run += v4[i]; v4[i] = run; }
        float inc = run;
#pragma unroll
        for (int o = 1; o < 64; o <<= 1) { const float nb = __shfl_up(inc, o); if (lane >= o) inc += nb; }
        float* wtot = ws + 48;
        float* wsum = (float*)(lds + A_OFF_Q) + 16;
        (void)wtot;
        if (lane == 63) wsum[wid] = inc;
        __syncthreads();
        float basew = 0.f;
#pragma unroll
        for (int i = 0; i < 8; ++i) basew += i < wid ? wsum[i] : 0.f;
        const float excl = basew + inc - run;
#pragma unroll
        for (int i = 0; i < 4; ++i) cum_l[tid * 4 + i] = -(excl + v4[i]) * LOG2E;
    }
    __syncthreads();
    if (MODE == 1) selm = ((const unsigned*)(lds + A_OFF_SEL))[qlo - q0 + r32];
    for (int t = 0; t < NT; ++t) {
        const int bf = t & 1, kb = (j_lo + t) * 64;
        if (t + 1 < NT) A_LOAD(kb + 64);
        const bool act = kb <= qlo + 31 && (MODE != 0 || kb + 63 >= qlo - 511);
        if (act) {
            f32x16 p0, p1;
            a_qkt(p0, p1, K_lds + bf * A_SHM, r32, hi, qr);
            const int dq = qlo + r32 - kb - 4 * hi;
            if (MODE == 2) {
                const float* ck = cum_l + kb + 4 * hi;
#pragma unroll
                for (int i = 0; i < 4; ++i) {
                    const f32x4 c0 = *(const f32x4*)(ck + 8 * i), c1 = *(const f32x4*)(ck + 32 + 8 * i);
#pragma unroll
                    for (int j = 0; j < 4; ++j) { p0[4 * i + j] = fmaf(p0[4 * i + j], C2, c0[j]); p1[4 * i + j] = fmaf(p1[4 * i + j], C2, c1[j]); }
                }
            } else {
                const bool far = qlo - (kb + 63) >= 113;
                if (far) {
                    const float cf = (MODE == 1 && !((selm >> (j_lo + t)) & 1u)) ? -__builtin_inff() : c31;
#pragma unroll
                    for (int r = 0; r < 16; ++r) { p0[r] = fmaf(p0[r], C2, cf); p1[r] = fmaf(p1[r], C2, cf); }
                } else {
#pragma unroll
                    for (int r = 0; r < 16; ++r) {
                        const int c = (r & 3) + 8 * (r >> 2);
                        const int d0i = min(max(dq - c, 0), 127), d1i = min(max(dq - c - 32, 0), 127);
                        p0[r] = fmaf(p0[r], C2, tbl[d0i]); p1[r] = fmaf(p1[r], C2, tbl[d1i]);
                    }
                }
            }
            const bool needmask = (kb + 63 > qlo) || (MODE == 0 && (qlo + 31 - kb) >= 512);
            if (needmask) {
                const float NEG = -__builtin_inff();
#pragma unroll
                for (int r = 0; r < 16; ++r) {
                    const int c = (r & 3) + 8 * (r >> 2);
                    if ((unsigned)(dq - c) >= WMASK) p0[r] = NEG;
                    if ((unsigned)(dq - c - 32) >= WMASK) p1[r] = NEG;
                }
            }
            if (MODE == 1 && !(qlo - (kb + 63) >= 113)) {
                if (!((selm >> (j_lo + t)) & 1u)) {
                    const float NEG = -__builtin_inff();
#pragma unroll
                    for (int r = 0; r < 16; ++r) { p0[r] = NEG; p1[r] = NEG; }
                }
            }
            float pmax = p0[0];
#pragma unroll
            for (int r = 1; r < 16; ++r) pmax = fmaxf(pmax, p0[r]);
#pragma unroll
            for (int r = 0; r < 16; ++r) pmax = fmaxf(pmax, p1[r]);
            { auto rr = __builtin_amdgcn_permlane32_swap(__float_as_uint(pmax), __float_as_uint(pmax), false, false);
              pmax = fmaxf(__uint_as_float(rr[0]), __uint_as_float(rr[1])); }
            float mn, alpha;
            if (__all(pmax - m_reg <= THR2)) { mn = m_reg; alpha = 1.f; }
            else { mn = fmaxf(m_reg, pmax); alpha = __builtin_amdgcn_exp2f(m_reg - mn); m_reg = mn; }
#pragma unroll
            for (int r = 0; r < 16; ++r) { p0[r] = __builtin_amdgcn_exp2f(p0[r] - mn); p1[r] = __builtin_amdgcn_exp2f(p1[r] - mn); }
            float ps = 0.f;
#pragma unroll
            for (int r = 0; r < 16; ++r) ps += p0[r];
#pragma unroll
            for (int r = 0; r < 16; ++r) ps += p1[r];
            { auto rr = __builtin_amdgcn_permlane32_swap(__float_as_uint(ps), __float_as_uint(ps), false, false);
              ps = __uint_as_float(rr[0]) + __uint_as_float(rr[1]); }
            l_reg = l_reg * alpha + ps;
            bf16x8 pa0, pa1, pa2, pa3;
#define A_PK4(P_, B_, OUT) do { unsigned a0 = cvt_pk_bf16(P_[B_ + 0], P_[B_ + 1]), a1 = cvt_pk_bf16(P_[B_ + 2], P_[B_ + 3]); \
        unsigned b0 = cvt_pk_bf16(P_[B_ + 4], P_[B_ + 5]), b1 = cvt_pk_bf16(P_[B_ + 6], P_[B_ + 7]); \
        auto r0 = __builtin_amdgcn_permlane32_swap(a0, b0, false, false); auto r1 = __builtin_amdgcn_permlane32_swap(a1, b1, false, false); \
        u32x4 w_ = {r0[0], r1[0], r0[1], r1[1]}; OUT = *reinterpret_cast<bf16x8*>(&w_); } while (0)
            A_PK4(p0, 0, pa0); A_PK4(p0, 8, pa1); A_PK4(p1, 0, pa2); A_PK4(p1, 8, pa3);
#undef A_PK4
            if (__any(alpha < 1.f)) {
                if (hi == 0) al_l[r32] = alpha;
                asm volatile("s_waitcnt lgkmcnt(0)" ::: "memory");
#pragma unroll
                for (int r = 0; r < 16; ++r) { const float a = al_l[a_crow(r, hi)];
#pragma unroll
                    for (int d_ = 0; d_ < 4; ++d_) o[d_][r] *= a; }
            }
            a_pv(o, vb0 + bf * A_SHM, pa0, pa1, pa2, pa3);
        }
        if (t + 1 < NT) A_WRITE(bf ^ 1);
        __syncthreads();
    }
#undef A_LOAD
#undef A_WRITE
    if (hi == 0) li_l[r32] = l_reg;
    asm volatile("s_waitcnt lgkmcnt(0)" ::: "memory");
    bf16_t* obuf = (MODE == 0 ? p.owinb : MODE == 1 ? p.oslcb : p.ofoxb) + (size_t)(b * S + qlo) * 1024 + h * DH;
#pragma unroll
    for (int r = 0; r < 16; ++r) {
        const int orow = a_crow(r, hi);
        const float rl = __builtin_amdgcn_rcpf(li_l[orow]);
#pragma unroll
        for (int d0 = 0; d0 < 4; ++d0) {
            const float v = o[d0][r] * rl;
            const float vn = __shfl_xor(v, 1);
            if ((r32 & 1) == 0) *(unsigned*)(obuf + (size_t)orow * 1024 + d0 * 32 + r32) = cvt_pk_bf16(v, vn);
        }
    }
}

__device__ __forceinline__ int next_unit(int* ctr, char* lds) {
    int* slot = (int*)(lds + A_OFF_Q);
    __syncthreads();
    if (threadIdx.x == 0) *slot = atomicAdd(ctr, 1);
    __syncthreads();
    return __builtin_amdgcn_readfirstlane(*slot);
}
constexpr int A_OFF_SLAB = 81920;
__device__ __forceinline__ void cmpattn_unit(const P& p, int b, int g, int qb, char* lds) {
    int tid = threadIdx.x; asm volatile("" : "+v"(tid));
    const int wid = __builtin_amdgcn_readfirstlane(tid >> 6), lane = tid & 63, r32 = lane & 31, hi = lane >> 5;
    const int hl = wid >> 1, h = g * R + hl, q0 = qb * 64, qlo = q0 + 32 * (wid & 1), tq = qlo + r32;
    const int nk = min(NCMP, 4 * qb + 3), NT = (nk + 63) >> 6;
    char* V_lds = lds + A_OFF_V; char* K_lds = lds + A_OFF_K;
    float* ws = (float*)(lds + A_OFF_WS) + wid * 64; float* li_l = ws;
    const float* tbl = (const float*)(lds + A_OFF_TBL) + h * 128;
    float* slab = (float*)(lds + A_OFF_SLAB);
    bf16x8 qr[8];
    {
        const bf16_t* qrow = p.projb + (size_t)(b * S + tq) * IN_PAD + OFF_QN + h * DH + hi * 8;
#pragma unroll
        for (int d0 = 0; d0 < 8; ++d0) qr[d0] = *reinterpret_cast<const bf16x8*>(qrow + d0 * 16);
    }
    const int sr = tid >> 4, sc = (tid & 15) * 8;
    const int kws = A_KSWZ(sr, sc * 2), vst0 = a_v_st(sr, sc), vst1 = a_v_st(32 + sr, sc);
    __syncthreads();
    {
        f32x4* z = (f32x4*)slab;
#pragma unroll
        for (int i = 0; i < 4; ++i) z[tid + i * NTHR] = (f32x4){0.f, 0.f, 0.f, 0.f};
        bf16x8 sk0[2], sk1[2], sv0[2], sv1[2];
#pragma unroll
        for (int t = 0; t < 2; ++t) {
            const int n0 = min(t * 64 + sr, NCMP - 1), n1 = min(t * 64 + 32 + sr, NCMP - 1);
            const bf16_t* k0p = p.cmpb + ((size_t)((b * NCMP + n0) * G + g)) * DH + sc;
            const bf16_t* k1p = p.cmpb + ((size_t)((b * NCMP + n1) * G + g)) * DH + sc;
            sk0[t] = *reinterpret_cast<const bf16x8*>(k0p); sk1[t] = *reinterpret_cast<const bf16x8*>(k1p);
            sv0[t] = *reinterpret_cast<const bf16x8*>(k0p + (size_t)1024 * DH); sv1[t] = *reinterpret_cast<const bf16x8*>(k1p + (size_t)1024 * DH);
        }
#pragma unroll
        for (int t = 0; t < 2; ++t) {
            if (t < NT) {
                *(bf16x8*)(K_lds + t * A_SHM + kws) = sk0[t]; *(bf16x8*)(K_lds + t * A_SHM + kws + 32 * 256) = sk1[t];
                *(bf16x8*)(V_lds + t * A_SHM + vst0) = sv0[t]; *(bf16x8*)(V_lds + t * A_SHM + vst1) = sv1[t];
            }
        }
    }
    __syncthreads();
    constexpr float C2 = LOG2E * SCALE;
    const float c31 = tbl[127];
    const float NEG = -__builtin_inff();
    f32x16 pp[4];
#pragma unroll
    for (int t = 0; t < 2; ++t) {
        if (t < NT) {
            a_qkt(pp[2 * t], pp[2 * t + 1], K_lds + t * A_SHM, r32, hi, qr);
#pragma unroll
            for (int a = 0; a < 2; ++a) {
                const int nb = t * 64 + a * 32;
                const int dq = tq - 31 - 16 * (nb + 4 * hi);
                const bool far = (qlo - 31 - 16 * (nb + 31)) >= 113;
                if (far) {
#pragma unroll
                    for (int r = 0; r < 16; ++r) pp[2 * t + a][r] = fmaf(pp[2 * t + a][r], C2, c31);
                } else {
#pragma unroll
                    for (int r = 0; r < 16; ++r) {
                        const int c = (r & 3) + 8 * (r >> 2);
                        const int d = dq - 16 * c;
                        const float x = fmaf(pp[2 * t + a][r], C2, tbl[min(max(d, 0), 127)]);
                        pp[2 * t + a][r] = d < 0 ? NEG : x;
                    }
                }
            }
        } else {
#pragma unroll
            for (int r = 0; r < 16; ++r) { pp[2 * t][r] = NEG; pp[2 * t + 1][r] = NEG; }
        }
    }
    float pmax = NEG;
#pragma unroll
    for (int a = 0; a < 4; ++a)
#pragma unroll
        for (int r = 0; r < 16; ++r) pmax = fmaxf(pmax, pp[a][r]);
    { auto rr = __builtin_amdgcn_permlane32_swap(__float_as_uint(pmax), __float_as_uint(pmax), false, false);
      pmax = fmaxf(__uint_as_float(rr[0]), __uint_as_float(rr[1])); }
    const float mn = fmaxf(pmax, -1e30f);
    float ps = 0.f;
#pragma unroll
    for (int a = 0; a < 4; ++a)
#pragma unroll
        for (int r = 0; r < 16; ++r) { pp[a][r] = __builtin_amdgcn_exp2f(pp[a][r] - mn); ps += pp[a][r]; }
    { auto rr = __builtin_amdgcn_permlane32_swap(__float_as_uint(ps), __float_as_uint(ps), false, false);
      ps = __uint_as_float(rr[0]) + __uint_as_float(rr[1]); }
    const float inv_l = ps > 0.f ? __builtin_amdgcn_rcpf(ps) : 0.f;
    {
        float* sl = slab + (size_t)(hl * 32) * 64 + (32 * (wid & 1) + r32);
#pragma unroll
        for (int a = 0; a < 4; ++a)
#pragma unroll
            for (int i = 0; i < 4; ++i) {
                const int j = 8 * a + 2 * i + hi;
                const float A = ((pp[a][4 * i] + pp[a][4 * i + 1]) + (pp[a][4 * i + 2] + pp[a][4 * i + 3])) * inv_l;
                const float L = pp[a][4 * i + 3] * inv_l;
                atomicAdd(sl + j * 64, A);
                if (j < 31) atomicAdd(sl + (j + 1) * 64, L);
            }
    }
    f32x16 o[4] = {};
    const int vb0 = (int)(uintptr_t)V_lds + a_v_rd_base(lane);
#define C_PK4(P_, B_, OUT) do { unsigned a0 = cvt_pk_bf16(P_[B_ + 0], P_[B_ + 1]), a1 = cvt_pk_bf16(P_[B_ + 2], P_[B_ + 3]); \
        unsigned b0 = cvt_pk_bf16(P_[B_ + 4], P_[B_ + 5]), b1 = cvt_pk_bf16(P_[B_ + 6], P_[B_ + 7]); \
        auto r0 = __builtin_amdgcn_permlane32_swap(a0, b0, false, false); auto r1 = __builtin_amdgcn_permlane32_swap(a1, b1, false, false); \
        u32x4 w_ = {r0[0], r1[0], r0[1], r1[1]}; OUT = *reinterpret_cast<bf16x8*>(&w_); } while (0)
#pragma unroll
    for (int t = 0; t < 2; ++t) {
        if (t < NT) {
            bf16x8 pa0, pa1, pa2, pa3;
            C_PK4(pp[2 * t], 0, pa0); C_PK4(pp[2 * t], 8, pa1); C_PK4(pp[2 * t + 1], 0, pa2); C_PK4(pp[2 * t + 1], 8, pa3);
            a_pv(o, vb0 + t * A_SHM, pa0, pa1, pa2, pa3);
        }
    }
#undef C_PK4
    if (hi == 0) li_l[r32] = inv_l;
    asm volatile("s_waitcnt lgkmcnt(0)" ::: "memory");
    bf16_t* obuf = p.ocmpb + (size_t)(b * S + qlo) * 1024 + h * DH;
#pragma unroll
    for (int r = 0; r < 16; ++r) {
        const int orow = a_crow(r, hi);
        const float rl = li_l[orow];
#pragma unroll
        for (int d0 = 0; d0 < 4; ++d0) {
            const float v = o[d0][r] * rl;
            const float vn = __shfl_xor(v, 1);
            if ((r32 & 1) == 0) *(unsigned*)(obuf + (size_t)orow * 1024 + d0 * 32 + r32) = cvt_pk_bf16(v, vn);
        }
    }
    __syncthreads();
    float* impS = (float*)K_lds;
    unsigned* selw = (unsigned*)(lds + A_OFF_SEL);
    {
        const int cur = qb;
#pragma unroll
        for (int i = 0; i < 4; ++i) {
            const int j = wid * 4 + i;
            float s = 0.f;
#pragma unroll
            for (int hh = 0; hh < 4; ++hh) s += slab[(hh * 32 + j) * 64 + lane];
            const bool forced = (j == 0) || (j == cur) || (j == cur - 1);
            impS[j * 64 + lane] = forced ? 1e6f : (j <= cur ? s : -1e6f);
        }
        if (wid == 0) selw[lane] = 0u;
    }
    __syncthreads();
    {
        float imp[32];
#pragma unroll
        for (int j = 0; j < 32; ++j) imp[j] = impS[j * 64 + lane];
        unsigned mask = 0;
#pragma unroll
        for (int i = 0; i < 4; ++i) {
            const int j = wid * 4 + i;
            const float mine = impS[j * 64 + lane];
            int rank = 0;
#pragma unroll
            for (int j2 = 0; j2 < 32; ++j2) rank += (imp[j2] > mine || (imp[j2] == mine && j2 < j)) ? 1 : 0;
            mask |= rank < 16 ? (1u << j) : 0u;
        }
        atomicOr(&selw[lane], mask);
    }
}

constexpr int CMP_KS = 8;
__device__ __forceinline__ void cmp1_unit(const P& p, char* shm, int u) {
    {
        const int ks = u % CMP_KS, mt = (u / CMP_KS) & 3, kv = u / (4 * CMP_KS);
        const bf16_t* A = p.projb + (kv ? OFF_VC : OFF_KC);
        float* C = p.hidp + ((size_t)(kv * CMP_KS + ks) * 1024 + mt * 256) * CMPH;
        gemm256<false>(A,
                [=](int r) { int m = mt * 256 + r; m = m < CMPR ? m : CMPR - 1; const int g = m & 1, bn = m >> 1, n = bn % NCMP, b = bn / NCMP; return (b * S + 16 * n) * IN_PAD + g * DH; },
                [=](int kt) { const int ka = ks * (4096 / CMP_KS / G_BK) + kt; return (ka >> 1) * IN_PAD + (ka & 1) * G_BK; },
                p.w1T + (size_t)kv * CMPH * 4096 + ks * (4096 / CMP_KS), 4096, 4096 / CMP_KS, shm,
                [=](const f32x4 (&acc)[2][2][4][2], int wr, int wc, int fr, int fq) {
#pragma unroll
                    for (int ai = 0; ai < 2; ++ai)
#pragma unroll
                        for (int m = 0; m < 4; ++m)
#pragma unroll
                            for (int bj = 0; bj < 2; ++bj)
#pragma unroll
                                for (int n = 0; n < 2; ++n)
                                    *(f32x4*)(C + (size_t)(ai * 128 + wr * 64 + m * 16 + fr) * CMPH + bj * 128 + wc * 32 + n * 16 + fq * 4) = acc[ai][bj][m][n];
                });
    }
}
__device__ __forceinline__ void ph_cmp_bias(const P& p, float* lds) {
    const int tid = threadIdx.x, tx = tid & 15, ty = tid >> 4;
    for (int u = blockIdx.x; u < 8; u += gridDim.x) {
        const int kv = u >> 2, n0 = (u & 3) * 64 + tx * 4;
        const float* pos = kv ? p.cmp_pos_v : p.cmp_pos_k; const float* w1 = kv ? p.cmp_v_w1 : p.cmp_k_w1;
        float a0 = 0.f, a1 = 0.f, a2 = 0.f, a3 = 0.f;
#pragma unroll 4
        for (int k = ty * 128; k < ty * 128 + 128; ++k) {
            const float4 w = *(const float4*)(w1 + (size_t)k * CMPH + n0); const float pv = pos[k];
            a0 += pv * w.x; a1 += pv * w.y; a2 += pv * w.z; a3 += pv * w.w;
        }
        __syncthreads();
        lds[ty * 64 + tx * 4 + 0] = a0; lds[ty * 64 + tx * 4 + 1] = a1; lds[ty * 64 + tx * 4 + 2] = a2; lds[ty * 64 + tx * 4 + 3] = a3;
        __syncthreads();
        if (tid < 64) { float s = 0.f; for (int i = 0; i < 32; ++i) s += lds[i * 64 + tid]; p.bias1[kv * CMPH + (u & 3) * 64 + tid] = s; }
        __syncthreads();
    }
}
__device__ __forceinline__ void cmp2_block_unit(const P& p, float* lds, int j) {
    int tid = threadIdx.x; asm volatile("" : "+v"(tid));
    const int w = tid >> 6, lane = tid & 63;
    float* hs = lds + w * 1024;
    const int kv = j >> 5, r0 = (j & 31) * 32 + w * 4;
    if (r0 < CMPR) {
        const f32x4 b1 = *(const f32x4*)(p.bias1 + kv * CMPH + lane * 4);
#pragma unroll 2
        for (int q = 0; q < 4; ++q) {
            f32x4 s = b1;
#pragma unroll
            for (int ks = 0; ks < CMP_KS; ++ks) s += *(const f32x4*)(p.hidp + ((size_t)(kv * CMP_KS + ks) * 1024 + r0 + q) * CMPH + lane * 4);
            f32x4 g; for (int j = 0; j < 4; ++j) g[j] = gelu_tanh(s[j]);
            *(f32x4*)(hs + q * 256 + lane * 4) = g;
        }
        const float* w2 = kv ? p.cmp_v_w2 : p.cmp_k_w2;
        float o[4][2] = {};
        for (int k0 = 0; k0 < CMPH; k0 += 32) {
            float2 wv[32];
#pragma unroll
            for (int i = 0; i < 32; ++i) wv[i] = *(const float2*)(w2 + (size_t)(k0 + i) * DH + 2 * lane);
#pragma unroll
            for (int i8 = 0; i8 < 32; i8 += 8) {
#pragma unroll
                for (int i = i8; i < i8 + 8; ++i)
#pragma unroll
                    for (int q = 0; q < 4; ++q) { const float hv = hs[q * 256 + k0 + i]; o[q][0] += hv * wv[i].x; o[q][1] += hv * wv[i].y; }
                __builtin_amdgcn_sched_barrier(0);
            }
        }
#pragma unroll
        for (int q = 0; q < 4; ++q) {
            float v0 = o[q][0], v1 = o[q][1];
            if (kv == 0) { const float rs = rsqrtf(wave_sum(v0 * v0 + v1 * v1) / DH + EPS); v0 *= rs * p.nsa_k_norm[2 * lane]; v1 *= rs * p.nsa_k_norm[2 * lane + 1]; }
            *(unsigned*)(p.cmpb + ((size_t)kv * 1024 + r0 + q) * DH + 2 * lane) = pk_bf16(v0, v1);
        }
    }
}

__device__ __forceinline__ void sync_publish(unsigned* ctr) {
    asm volatile("s_waitcnt vmcnt(0)" ::: "memory");
    __syncthreads();
    if (threadIdx.x == 0) {
        __builtin_amdgcn_fence(__ATOMIC_RELEASE, "agent");
        asm volatile("s_waitcnt vmcnt(0)" ::: "memory");
        (void)__hip_atomic_fetch_add(ctr, 1u, __ATOMIC_RELAXED, __HIP_MEMORY_SCOPE_AGENT);
    }
}
__device__ __forceinline__ void sync_wait_ge(unsigned* ctr, unsigned target) {
    if (threadIdx.x == 0) {
        unsigned sp = 0;
        while (__hip_atomic_load(ctr, __ATOMIC_RELAXED, __HIP_MEMORY_SCOPE_AGENT) < target) { __builtin_amdgcn_s_sleep(1); if (++sp > (1u << 22)) break; }
        __builtin_amdgcn_fence(__ATOMIC_ACQUIRE, "agent");
        asm volatile("s_waitcnt vmcnt(0)" ::: "memory");
    }
    __syncthreads();
}
constexpr int SY_CMP1 = 0, SY_CMP2 = 8;
__device__ __forceinline__ void ph_attention(const P& p, char* lds, int qo = 0) {
    unsigned* sy = p.sync;
    if (blockIdx.x < 2 * 4 * CMP_KS) {
        const int u = blockIdx.x;
        cmp1_unit(p, lds, u);
        sync_publish(sy + (SY_CMP1 + (u / CMP_KS)) * 64);
        const int kv2 = u >> 5, mt2 = (u & 31) >> 3;
        sync_wait_ge(sy + (SY_CMP1 + kv2 * 4 + mt2) * 64, CMP_KS);
        cmp2_block_unit(p, (float*)lds, u);
        sync_publish(sy + SY_CMP2 * 64);
        __syncthreads();
    }
    for (int u = ((int)blockIdx.x + (int)gridDim.x - 2 * 4 * CMP_KS) % (int)gridDim.x; u < 256; u += gridDim.x) {
        const int bh = u & 31;
        attn_unit<2>(p, bh >> 3, bh & 7, 7 - (u >> 5), lds);
    }
    a_build_tbl(p, lds);
    sync_wait_ge(sy + SY_CMP2 * 64, 2 * 4 * CMP_KS);
    for (;;) {
        const int u = next_unit(p.queue + 16 + qo, lds);
        if (u >= 512) break;
        const int bg = u & 7, qb = 31 - ((u & 255) >> 3);
        if (u < 256) { cmpattn_unit(p, bg >> 1, bg & 1, qb, lds); attn_unit<1>(p, bg >> 1, bg & 1, qb, lds); }
        else attn_unit<0>(p, bg >> 1, bg & 1, qb, lds);
    }
}

constexpr int LDS_BAR_OFF = 139776;
constexpr int LDS_TOTAL = LDS_BAR_OFF + 64;
__global__ void __launch_bounds__(NTHR, 2) k_mega(P p) {
    extern __shared__ __attribute__((aligned(16))) char shm[];
    float* lds = (float*)shm;
    volatile LAS unsigned* xbw = (volatile LAS unsigned*)(shm + LDS_BAR_OFF);
    if (threadIdx.x == 0) { xbw[0] = 0u; xbw[1] = 0u; xbw[2] = 0u; xbw[3] = 0u; }
    __syncthreads();
    XcdBarrier bar = xcd_barrier_post(p.bar, xbw);
    ph_mod(p, lds); __syncthreads(); ph_cmp_bias(p, lds); __syncthreads(); ph_convert(p, shm);   xcd_barrier(bar);
    ph_rms1_b(p, lds);                               xcd_barrier(bar);
    ph_inproj_fast(p, shm);                          xcd_barrier(bar);
    ph_attention(p, shm);                            xcd_barrier(bar);
    ph_combine(p, lds);                              xcd_barrier(bar);
    ph_outproj_fast(p, shm);                         xcd_barrier(bar);
    ph_router_fast(p, shm);                          xcd_barrier(bar);
    ph_up_fast(p, shm);                              xcd_barrier(bar);
    ph_down_fast(p, shm);                            xcd_barrier(bar);
    ph_final_fast(p);
}
}

extern "C" void kernel_launch(void* const* d_in, const int* in_sizes, int n_in, void* d_out, int out_size, void* d_ws, size_t ws_size,
                              hipStream_t stream) {
    (void)in_sizes; (void)n_in; (void)out_size;
    P p{};
    const float* const* in = (const float* const*)d_in;
    p.x = in[0]; p.c = in[1]; p.rel_bias = in[2]; p.mod_w = in[3]; p.mod_b = in[4]; p.norm_attn = in[5]; p.norm_moe = in[6]; p.w_in = in[7];
    p.b_nsa_gate = in[8]; p.nsa_q_norm = in[9]; p.nsa_k_norm = in[10]; p.cmp_pos_k = in[11]; p.cmp_pos_v = in[12]; p.cmp_k_w1 = in[13];
    p.cmp_k_w2 = in[14]; p.cmp_v_w1 = in[15]; p.cmp_v_w2 = in[16]; p.fox_q_norm = in[17]; p.fox_k_norm = in[18]; p.fox_forget_bias = in[19];
    p.out_norm = in[20]; p.w_out = in[21]; p.router_w = in[22]; p.router_b = in[23]; p.w_up = in[24]; p.b_up = in[25]; p.w_down = in[26];
    p.b_down = in[27];
    p.out = (float*)d_out;
    char* ws = (char*)d_ws; size_t off = 0;
    auto take = [&](size_t bytes) { void* r = ws + off; off += (bytes + 255) & ~(size_t)255; return r; };
    p.bar = (unsigned*)take(XCD_BAR_WORDS * sizeof(unsigned));
    p.queue = (int*)take(64 * sizeof(int));
    p.cnt = (int*)take(NE * 64 * sizeof(int));
    p.sync = (unsigned*)take(16 * 64 * sizeof(unsigned));
    const size_t zero_bytes = off;
    p.mod = (float*)take((size_t)NB * 6 * D * 4);
    p.cum = (float*)take((size_t)NB * 8 * S * 4);
    p.x1 = (bf16_t*)take((size_t)T * D * 2);
    p.row_w = (float*)take((size_t)NE * CAP * 4);
    p.row_a = (int*)take((size_t)NE * CAP * 4);
    p.gatesf = (float*)take((size_t)T * 24 * 4);
    p.logf = (float*)take((size_t)T * 8 * 4);
    p.hidp = (float*)take((size_t)2 * CMP_KS * 1024 * CMPH * 4);
    p.bias1 = (float*)take((size_t)2 * CMPH * 4);
    p.winT = (bf16_t*)take((size_t)IN_PAD * D * 2);
    p.woutT = (bf16_t*)take((size_t)D * D * 2);
    p.w1T = (bf16_t*)take((size_t)2 * CMPH * 4096 * 2);
    p.w2T = (bf16_t*)take((size_t)2 * 256 * CMPH * 2);
    p.hb = (bf16_t*)take((size_t)T * D * 2);
    p.projb = (bf16_t*)take((size_t)T * IN_PAD * 2);
    p.mixb = (bf16_t*)take((size_t)T * D * 2);
    p.owinb = (bf16_t*)take((size_t)T * 1024 * 2);
    p.oslcb = (bf16_t*)take((size_t)T * 1024 * 2);
    p.ofoxb = (bf16_t*)take((size_t)T * 1024 * 2);
    p.ocmpb = (bf16_t*)take((size_t)T * 1024 * 2);
    p.cmpb = (bf16_t*)take((size_t)2 * 1024 * DH * 2);
    p.yq = (unsigned char*)take((size_t)TK * D);
    p.wupq = (unsigned char*)take((size_t)NE * 2 * F * D);
    p.wdnq = (unsigned char*)take((size_t)NE * D * F);
    p.xgq = (unsigned char*)take((size_t)NE * CAP * D);
    p.actq = (unsigned char*)take((size_t)NE * CAP * F);
    p.winq = (unsigned char*)take((size_t)IN_PAD * D);
    p.hq = (unsigned char*)take((size_t)T * D);
    if (off > ws_size) { fprintf(stderr, "kernel_launch: workspace too small (%zu > %zu)\n", off, ws_size); return; }

    constexpr size_t kDynLds = LDS_TOTAL;
    constexpr int kBlocksPerCu = 1;
    static int grid = 0;
    if (!grid) {
        int dev = 0, cus = 0, per_cu = 0;
        (void)hipGetDevice(&dev);
        (void)hipDeviceGetAttribute(&cus, hipDeviceAttributeMultiprocessorCount, dev);
        (void)hipFuncSetAttribute((const void*)k_mega, hipFuncAttributeMaxDynamicSharedMemorySize, (int)kDynLds);
        (void)hipOccupancyMaxActiveBlocksPerMultiprocessor(&per_cu, k_mega, NTHR, kDynLds);
        if (cus <= 0) cus = 256;
        if (per_cu < 1) per_cu = 1;
        grid = cus * (per_cu < kBlocksPerCu ? per_cu : kBlocksPerCu);
    }
    (void)hipMemsetAsync(ws, 0, zero_bytes, stream);
    k_mega<<<grid, NTHR, kDynLds, stream>>>(p);
}
```

```cpp
#include <hip/hip_runtime.h>
#include <stdint.h>
#include <stdio.h>

#define XB_TMO      128
#define XB_XCNT(j)  (256  + 64 * (j))
#define XB_XSUB(j)  (1280 + 64 * (j))
#define XB_XGEN(j)  (2304 + 64 * (j))
#define XB_TOP      3328
#define XB_TOPGEN   3392
#define XCD_BAR_WORDS 3456
#define XB_SPIN_CAP (1u << 18)
#define LAS __attribute__((address_space(3)))

__device__ __forceinline__ unsigned xb_ld(unsigned* p)              { return __hip_atomic_load(p, __ATOMIC_RELAXED, __HIP_MEMORY_SCOPE_AGENT); }
__device__ __forceinline__ unsigned xb_add(unsigned* p, unsigned v) { return __hip_atomic_fetch_add(p, v, __ATOMIC_RELAXED, __HIP_MEMORY_SCOPE_AGENT); }
__device__ __forceinline__ unsigned xb_xcc_id() { return (unsigned)__builtin_amdgcn_s_getreg((3 << 11) | 20) & 0xFu; }
#define XB_SPIN(cond, bar) do { unsigned _sp = 0; while (cond) { __builtin_amdgcn_s_sleep(1); \
    if ((++_sp & 255u) == 0u) { if (xb_ld(&(bar)[XB_TMO])) break; if (_sp > XB_SPIN_CAP) { atomicAdd(&(bar)[XB_TMO], 1u); break; } } } } while (0)

struct XcdBarrier {
    unsigned* bar; unsigned x;
    volatile LAS unsigned* st;
};

__device__ __forceinline__ XcdBarrier xcd_barrier_post(unsigned* bar, volatile LAS unsigned* st) {
    XcdBarrier b; b.bar = bar; b.x = xb_xcc_id(); b.st = st;
    if (threadIdx.x == 0) (void)xb_add(&bar[XB_XCNT(b.x)], 1u);
    return b;
}
__device__ __forceinline__ void xcd_barrier_complete(unsigned* bar, unsigned x, unsigned& nloc, unsigned& nx) {
    const unsigned G = gridDim.x * gridDim.y * gridDim.z;
    unsigned sum, cnt, mine, sp = 0u;
    for (;;) {
        sum = 0u; cnt = 0u; mine = 0u;
#pragma unroll
        for (unsigned j = 0; j < 16; ++j) { const unsigned c = xb_ld(&bar[XB_XCNT(j)]); sum += c; cnt += (c > 0u) ? 1u : 0u; mine = (j == x) ? c : mine; }
        if (sum == G) break;
        __builtin_amdgcn_s_sleep(1);
        if ((++sp & 255u) == 0u) { if (xb_ld(&bar[XB_TMO])) break; if (sp > XB_SPIN_CAP) { atomicAdd(&bar[XB_TMO], 1u); break; } }
    }
    nloc = mine > 0u ? mine : 1u; nx = cnt > 0u ? cnt : 1u;
}

__device__ __forceinline__ void xcd_barrier(const XcdBarrier& b) {
    asm volatile("s_waitcnt vmcnt(0)" ::: "memory");
    __syncthreads();
    if (threadIdx.x == 0) {
        unsigned* bar = b.bar;
        __builtin_amdgcn_s_waitcnt(0);
        unsigned nloc = b.st[0], nx = b.st[1];
        if (nloc == 0u) { xcd_barrier_complete(bar, b.x, nloc, nx); b.st[0] = nloc; b.st[1] = nx; }
        const unsigned old = xb_add(&bar[XB_XSUB(b.x)], 1u);
        const unsigned gen = old / nloc;
        if (old + 1u == (gen + 1u) * nloc) {
            __builtin_amdgcn_fence(__ATOMIC_RELEASE, "agent");
            asm volatile("s_waitcnt vmcnt(0)" ::: "memory");
            const unsigned og = xb_add(&bar[XB_TOP], 1u);
            const unsigned tg = og / nx;
            if (og + 1u == (tg + 1u) * nx) xb_add(&bar[XB_TOPGEN], 1u);
            else XB_SPIN(xb_ld(&bar[XB_TOPGEN]) == tg, bar);
            __builtin_amdgcn_fence(__ATOMIC_ACQUIRE, "agent");
            xb_add(&bar[XB_XGEN(b.x)], 1u);
            asm volatile("s_waitcnt vmcnt(0)" ::: "memory");
        } else {
            XB_SPIN(xb_ld(&bar[XB_XGEN(b.x)]) == gen, bar);
            __builtin_amdgcn_fence(__ATOMIC_ACQUIRE, "agent");
            asm volatile("s_waitcnt vmcnt(0)" ::: "memory");
        }
    }
    __syncthreads();
}


namespace {
typedef unsigned short bf16_t;
typedef float f32x4 __attribute__((ext_vector_type(4)));
constexpr int D = 2048, NB = 4, S = 2048, T = NB * S;
constexpr int DH = 128, G = 2, R = 4;
constexpr int D_IN = 5664;
constexpr int OFF_QN = 0, OFF_KC = 1024, OFF_VC = 1280, OFF_KS = 1536, OFF_VS = 1792, OFF_KW = 2048, OFF_VW = 2304,
              OFF_QF = 2560, OFF_KF = 3584, OFF_VF = 4608, OFF_GN = 5632, OFF_FF = 5656;
__host__ __device__ constexpr int in_colmap(int n) { return n < 2560 ? n : n < 2584 ? 5632 + (n - 2560) : n < 5656 ? n - 24 : n; }
constexpr int NCMP = 127, CMPH = 256, CMPR = NB * NCMP * G;
constexpr int NE = 32, F = 2048, TK = T * 4;
constexpr float SCALE = 0.08838834764831845f;
constexpr float EPS = 1e-6f;
constexpr int NTHR = 512;

__device__ const unsigned char BUCKET[128] = {
 0, 1, 2, 3, 4, 5, 6, 7, 8, 9, 10, 11, 12, 13, 14, 15, 16, 16, 16, 17, 17, 18, 18, 18, 19, 19, 19, 20, 20, 20, 20, 21,
 21, 21, 21, 22, 22, 22, 22, 22, 23, 23, 23, 23, 23, 23, 24, 24, 24, 24, 24, 24, 25, 25, 25, 25, 25, 25, 25, 26, 26, 26, 26, 26,
 26, 26, 26, 27, 27, 27, 27, 27, 27, 27, 27, 27, 27, 28, 28, 28, 28, 28, 28, 28, 28, 28, 28, 29, 29, 29, 29, 29, 29, 29, 29, 29,
 29, 29, 29, 30, 30, 30, 30, 30, 30, 30, 30, 30, 30, 30, 30, 30, 30, 31, 31, 31, 31, 31, 31, 31, 31, 31, 31, 31, 31, 31, 31, 31};
__device__ __forceinline__ int t5bucket(int d) { return BUCKET[d > 127 ? 127 : d]; }

struct P {
    const float *x, *c, *rel_bias, *mod_w, *mod_b, *norm_attn, *norm_moe, *w_in, *b_nsa_gate, *nsa_q_norm, *nsa_k_norm,
        *cmp_pos_k, *cmp_pos_v, *cmp_k_w1, *cmp_k_w2, *cmp_v_w1, *cmp_v_w2, *fox_q_norm, *fox_k_norm, *fox_forget_bias,
        *out_norm, *w_out, *router_w, *router_b, *w_up, *b_up, *w_down, *b_down;
    float* out;
    float *mod, *cum, *row_w, *gatesf, *logf, *hidp, *bias1;
    int *cnt, *queue, *row_a; unsigned* bar; unsigned* sync;
    bf16_t *x1, *winT, *woutT, *w1T, *w2T, *hb, *projb, *mixb, *owinb, *oslcb, *ofoxb, *ocmpb, *cmpb;
    unsigned char *wupq, *wdnq, *xgq, *actq, *winq, *hq, *yq;
};

__device__ __forceinline__ float wave_sum(float v) {
#pragma unroll
    for (int o = 32; o > 0; o >>= 1) v += __shfl_xor(v, o);
    return v;
}
__device__ __forceinline__ float wave_max(float v) {
#pragma unroll
    for (int o = 32; o > 0; o >>= 1) v = fmaxf(v, __shfl_xor(v, o));
    return v;
}
__device__ __forceinline__ float bf2f(bf16_t v) { return __uint_as_float(((unsigned)v) << 16); }
__device__ __forceinline__ float bflo(unsigned w) { return __uint_as_float(w << 16); }
__device__ __forceinline__ float bfhi(unsigned w) { return __uint_as_float(w & 0xffff0000u); }
__device__ __forceinline__ unsigned pk_bf16(float lo, float hi) { unsigned r; asm("v_cvt_pk_bf16_f32 %0, %1, %2" : "=v"(r) : "v"(lo), "v"(hi)); return r; }
constexpr int IN_PAD = 5888;
__device__ __forceinline__ float block_sum(float v, float* red) {
    v = wave_sum(v);
    const int w = threadIdx.x >> 6;
    __syncthreads();
    if ((threadIdx.x & 63) == 0) red[w] = v;
    __syncthreads();
    float s = 0.f;
    for (int i = 0; i < (int)(blockDim.x >> 6); ++i) s += red[i];
    return s;
}

__device__ __forceinline__ void ph_mod(const P& p, float* lds) {
    const int tid = threadIdx.x, tx = tid & 15, ty = tid >> 4;
    float* sc = lds + 8192;
    if (blockIdx.x < 6 * D / 64) {
        for (int i = tid; i < 4 * D; i += NTHR) { const float cv = p.c[i]; sc[i] = cv / (1.f + __expf(-cv)); }
    }
    __syncthreads();
    for (int u = blockIdx.x; u < 6 * D / 64; u += gridDim.x) {
        const int n0 = u * 64 + tx * 4;
        float acc[4][4] = {};
        for (int k0 = ty * 64; k0 < ty * 64 + 64; k0 += 8) {
            float4 w[8];
#pragma unroll
            for (int i = 0; i < 8; ++i) w[i] = *(const float4*)(p.mod_w + (size_t)(k0 + i) * (6 * D) + n0);
#pragma unroll
            for (int i = 0; i < 8; ++i)
#pragma unroll
                for (int b = 0; b < 4; ++b) {
                    const float sv = sc[b * D + k0 + i];
                    acc[b][0] += sv * w[i].x; acc[b][1] += sv * w[i].y; acc[b][2] += sv * w[i].z; acc[b][3] += sv * w[i].w;
                }
        }
        __syncthreads();
#pragma unroll
        for (int b = 0; b < 4; ++b)
#pragma unroll
            for (int j = 0; j < 4; ++j) lds[(ty * 4 + b) * 64 + tx * 4 + j] = acc[b][j];
        __syncthreads();
        if (tid < 256) {
            const int b = tid >> 6, n = tid & 63;
            float s = 0.f;
            for (int i = 0; i < 32; ++i) s += lds[(i * 4 + b) * 64 + n];
            p.mod[b * 6 * D + u * 64 + n] = s + p.mod_b[u * 64 + n];
        }
    }
}

__device__ __forceinline__ void ph_rms1_b(const P& p, float* lds) {
    const int tid = threadIdx.x, w = tid >> 6, lane = tid & 63;
    for (int t = blockIdx.x * 8 + w; t < T; t += gridDim.x * 8) {
        const int b = t / S;
        f32x4 v[8]; float ss = 0.f;
#pragma unroll
        for (int i = 0; i < 8; ++i) { v[i] = *(const f32x4*)(p.x + (size_t)t * D + (i * 64 + lane) * 4); ss += v[i][0] * v[i][0] + v[i][1] * v[i][1] + v[i][2] * v[i][2] + v[i][3] * v[i][3]; }
        const float rs = rsqrtf(wave_sum(ss) / D + EPS);
        const float* scp = p.mod + (size_t)b * 6 * D + 1 * D; const float* shp = p.mod + (size_t)b * 6 * D;
#pragma unroll
        for (int i = 0; i < 8; ++i) {
            const int c = (i * 64 + lane) * 4;
            const f32x4 g = *(const f32x4*)(p.norm_attn + c), sc = *(const f32x4*)(scp + c), sh = *(const f32x4*)(shp + c);
            f32x4 o; for (int j = 0; j < 4; ++j) o[j] = v[i][j] * rs * g[j] * (1.f + sc[j]) + sh[j];
            int ow = 0; ow = __builtin_amdgcn_cvt_pk_fp8_f32(o[0], o[1], ow, false); ow = __builtin_amdgcn_cvt_pk_fp8_f32(o[2], o[3], ow, true);
            *(int*)(p.hq + (size_t)t * D + c) = ow;
            uint2 ob; ob.x = pk_bf16(o[0], o[1]); ob.y = pk_bf16(o[2], o[3]);
            *(uint2*)(p.hb + (size_t)t * D + c) = ob;
        }
    }
}

__device__ __forceinline__ float log_sigmoid(float x) { return fminf(x, 0.f) - log1pf(__expf(-fabsf(x))); }
__device__ __forceinline__ void ph_postproj(const P& p) {
    const int tid = threadIdx.x, w = tid >> 6, lane = tid & 63;
    for (int t = blockIdx.x * 8 + w; t < T; t += gridDim.x * 8) {
        bf16_t* row = p.projb + (size_t)t * IN_PAD;
        unsigned wv[28];
#pragma unroll
        for (int hh = 0; hh < 28; ++hh) {
            const int off = hh < 8 ? OFF_QN + hh * DH : hh < 10 ? OFF_KS + (hh - 8) * DH : hh < 12 ? OFF_KW + (hh - 10) * DH : hh < 20 ? OFF_QF + (hh - 12) * DH : OFF_KF + (hh - 20) * DH;
            wv[hh] = *(const unsigned*)(row + off + 2 * lane);
        }
        const float gate_in = lane < 24 ? bf2f(row[OFF_GN + lane]) : 0.f;
        const float f_in = lane < 8 ? bf2f(row[OFF_FF + lane]) : 0.f;
#pragma unroll
        for (int hh = 0; hh < 28; ++hh) {
            const int off = hh < 8 ? OFF_QN + hh * DH : hh < 10 ? OFF_KS + (hh - 8) * DH : hh < 12 ? OFF_KW + (hh - 10) * DH : hh < 20 ? OFF_QF + (hh - 12) * DH : OFF_KF + (hh - 20) * DH;
            const float* gw = hh < 8 ? p.nsa_q_norm : hh < 10 ? p.nsa_k_norm + DH : hh < 12 ? p.nsa_k_norm + 2 * DH : hh < 20 ? p.fox_q_norm : p.fox_k_norm;
            const float a = bflo(wv[hh]), b = bfhi(wv[hh]);
            const float rs = rsqrtf(wave_sum(a * a + b * b) / DH + EPS);
            const float2 g2 = *(const float2*)(gw + 2 * lane);
            *(unsigned*)(row + off + 2 * lane) = pk_bf16(a * rs * g2.x, b * rs * g2.y);
        }
        if (lane < 24) p.gatesf[(size_t)t * 24 + lane] = 1.f / (1.f + __expf(-(gate_in + p.b_nsa_gate[lane])));
        if (lane < 8) p.logf[(size_t)t * 8 + lane] = log_sigmoid(f_in + p.fox_forget_bias[lane]);
    }
}

__device__ __forceinline__ void ph_cumsum(const P& p, float* lds) {
    const int tid = threadIdx.x;
    for (int u = blockIdx.x; u < NB * 8; u += gridDim.x) {
        const int b = u >> 3, hh = u & 7;
        float v[4]; float s = 0.f;
#pragma unroll
        for (int i = 0; i < 4; ++i) { v[i] = p.logf[(size_t)(b * S + tid * 4 + i) * 8 + hh]; s += v[i]; v[i] = s; }
        __syncthreads();
        lds[tid] = s;
        __syncthreads();
        if (tid < 64) {
            float q[8], r = 0.f;
#pragma unroll
            for (int i = 0; i < 8; ++i) { q[i] = lds[tid * 8 + i]; r += q[i]; }
            float inc = r;
#pragma unroll
            for (int o = 1; o < 64; o <<= 1) { const float n = __shfl_up(inc, o); if (tid >= o) inc += n; }
            float run = inc - r;
#pragma unroll
            for (int i = 0; i < 8; ++i) { lds[tid * 8 + i] = run; run += q[i]; }
        }
        __syncthreads();
        const float base = lds[tid];
#pragma unroll
        for (int i = 0; i < 4; ++i) p.cum[(size_t)u * S + tid * 4 + i] = base + v[i];
        __syncthreads();
    }
}

__device__ __forceinline__ float gelu_tanh(float x) {
    const float u = 0.7978845608028654f * (x + 0.044715f * x * x * x);
    return 0.5f * x * (1.f + tanhf(u));
}
__device__ __forceinline__ void ph_combine(const P& p, float* lds) {
    const int tid = threadIdx.x, w = tid >> 6, lane = tid & 63;
    for (int t = blockIdx.x * 8 + w; t < T; t += gridDim.x * 8) {
        const float* gates = p.gatesf + (size_t)t * 24;
        float a[8][2], f[8][2]; float sa = 0.f, sf = 0.f;
#pragma unroll
        for (int i = 0; i < 8; ++i) {
            const size_t o = (size_t)t * 1024 + 2 * (i * 64 + lane);
            const float g0 = gates[i], g1 = gates[8 + i], g2 = gates[16 + i];
            const unsigned sw = *(const unsigned*)(p.oslcb + o), ww = *(const unsigned*)(p.owinb + o), fw = *(const unsigned*)(p.ofoxb + o);
            float c0, c1;
            { const unsigned cw = *(const unsigned*)(p.ocmpb + o); c0 = bflo(cw); c1 = bfhi(cw); }
            a[i][0] = g0 * c0 + g1 * bflo(sw) + g2 * bflo(ww); a[i][1] = g0 * c1 + g1 * bfhi(sw) + g2 * bfhi(ww);
            f[i][0] = bflo(fw); f[i][1] = bfhi(fw);
            sa += a[i][0] * a[i][0] + a[i][1] * a[i][1]; sf += f[i][0] * f[i][0] + f[i][1] * f[i][1];
        }
        const float ra = rsqrtf(wave_sum(sa) / 1024.f + EPS), rf = rsqrtf(wave_sum(sf) / 1024.f + EPS);
        bf16_t* mo = p.mixb + (size_t)t * D;
#pragma unroll
        for (int i = 0; i < 8; ++i) {
            const int c = 2 * (i * 64 + lane);
            const float2 n0 = *(const float2*)(p.out_norm + c), n1 = *(const float2*)(p.out_norm + 1024 + c);
            *(unsigned*)(mo + c) = pk_bf16(a[i][0] * ra * n0.x, a[i][1] * ra * n0.y);
            *(unsigned*)(mo + 1024 + c) = pk_bf16(f[i][0] * rf * n1.x, f[i][1] * rf * n1.y);
        }
    }
}

typedef short bf16x8 __attribute__((ext_vector_type(8)));
typedef float f32x16 __attribute__((ext_vector_type(16)));
typedef unsigned u32x4 __attribute__((ext_vector_type(4)));
typedef unsigned u32x2 __attribute__((ext_vector_type(2)));
typedef float f32x2 __attribute__((ext_vector_type(2)));

__device__ __forceinline__ unsigned cvt_pk_bf16(float lo, float hi) { unsigned r; asm("v_cvt_pk_bf16_f32 %0, %1, %2" : "=v"(r) : "v"(lo), "v"(hi)); return r; }
__device__ __forceinline__ float bf16_lo(unsigned w) { return __uint_as_float(w << 16); }
__device__ __forceinline__ float bf16_hi(unsigned w) { return __uint_as_float(w & 0xffff0000u); }
__device__ __forceinline__ float bf16_f(bf16_t v) { return __uint_as_float(((unsigned)v) << 16); }
__device__ __forceinline__ f32x4 bf16x4_f(u32x2 w) { return (f32x4){bf16_lo(w.x), bf16_hi(w.x), bf16_lo(w.y), bf16_hi(w.y)}; }

typedef int i32x8 __attribute__((ext_vector_type(8)));
typedef int i32x4 __attribute__((ext_vector_type(4)));
constexpr int F8_SCALE_W = 0x79797979, F8_SCALE_A = 0x7F7F7F7F;
constexpr float F8_WMUL = 64.f;
__device__ __forceinline__ int perm32(int rho) { const int n = rho >> 4, i = rho & 15; return 8 * (i >> 2) + 4 * n + (i & 3); }
constexpr unsigned long long CVT_IN_BF_TILES = 0x1FF0001CCC00ull, CVT_IN_F8_TILES = 0x1FFFF333FFull;
constexpr int CVT_N_IN_BF = 16, CVT_N_IN_F8 = 31;
__device__ __forceinline__ int nth_set_bit(unsigned long long m, int j) { int b = 0; for (;; ++b) if ((m >> b) & 1) { if (j-- == 0) break; } return b; }
constexpr int CVT_T_IN = 16 * CVT_N_IN_BF, CVT_T_INQ = 8 * CVT_N_IN_F8, CVT_T_OUT = 16 * 16, CVT_T_W1 = 32 * 2, CVT_T_W2 = 2 * 2, CVT_T_UP = 8 * 32, CVT_T_DN = 8 * 16;
constexpr int CVT_B_OUT = CVT_T_IN, CVT_B_W1K = CVT_B_OUT + CVT_T_OUT, CVT_B_W1V = CVT_B_W1K + CVT_T_W1, CVT_B_W2K = CVT_B_W1V + CVT_T_W1,
              CVT_B_W2V = CVT_B_W2K + CVT_T_W2, CVT_B_UP = CVT_B_W2V + CVT_T_W2, CVT_B_DN = CVT_B_UP + NE * CVT_T_UP, CVT_B_INQ = CVT_B_DN + NE * CVT_T_DN, CVT_TOTAL = CVT_B_INQ + CVT_T_INQ;

struct CvtTile { const float* src; bf16_t* dst; int ldn, K, nvalid, k0, n0, drow0, perm; };
__device__ __forceinline__ CvtTile cvt_decode(const P& p, int u) {
    CvtTile t; int local, nNt; int mode = 0; t.perm = (u >= CVT_B_INQ || u < CVT_B_OUT) ? 1 : 0;
    if (u < CVT_B_OUT) { local = u; nNt = CVT_N_IN_BF; t.src = p.w_in; t.dst = p.winT; t.ldn = D_IN; t.K = D; t.nvalid = D_IN; }
    else if (u >= CVT_B_INQ) { local = u - CVT_B_INQ; nNt = CVT_N_IN_F8; t.src = p.w_in; t.dst = (bf16_t*)p.winq; t.ldn = D_IN; t.K = D; t.nvalid = D_IN; }
    else if (u < CVT_B_W1K) { local = u - CVT_B_OUT; nNt = 16; t.src = p.w_out; t.dst = p.woutT; t.ldn = D; t.K = D; t.nvalid = D; }
    else if (u < CVT_B_W1V) { local = u - CVT_B_W1K; nNt = 2; t.src = p.cmp_k_w1; t.dst = p.w1T; t.ldn = CMPH; t.K = 4096; t.nvalid = CMPH; }
    else if (u < CVT_B_W2K) { local = u - CVT_B_W1V; nNt = 2; t.src = p.cmp_v_w1; t.dst = p.w1T + (size_t)CMPH * 4096; t.ldn = CMPH; t.K = 4096; t.nvalid = CMPH; }
    else if (u < CVT_B_W2V) { local = u - CVT_B_W2K; nNt = 2; t.src = p.cmp_k_w2; t.dst = p.w2T; t.ldn = DH; t.K = CMPH; t.nvalid = DH; }
    else if (u < CVT_B_UP) { local = u - CVT_B_W2V; nNt = 2; t.src = p.cmp_v_w2; t.dst = p.w2T + (size_t)256 * CMPH; t.ldn = DH; t.K = CMPH; t.nvalid = DH; }
    else if (u < CVT_B_DN) { const int l2 = u - CVT_B_UP, e = l2 / CVT_T_UP; local = l2 % CVT_T_UP; nNt = 32; mode = 1;
        t.src = p.w_up + (size_t)e * D * 2 * F; t.dst = (bf16_t*)(p.wupq + (size_t)e * 2 * F * D); t.ldn = 2 * F; t.K = D; t.nvalid = 2 * F; }
    else { const int l2 = u - CVT_B_DN, e = l2 / CVT_T_DN; local = l2 % CVT_T_DN; nNt = 16;
        t.src = p.w_down + (size_t)e * F * D; t.dst = (bf16_t*)(p.wdnq + (size_t)e * D * F); t.ldn = D; t.K = F; t.nvalid = D; }
    int nt = local % nNt; const int kt = local / nNt;
    if (u < CVT_B_OUT) nt = nth_set_bit(CVT_IN_BF_TILES, nt); else if (u >= CVT_B_INQ) nt = nth_set_bit(CVT_IN_F8_TILES, nt);
    t.k0 = kt * (u < CVT_B_UP ? 128 : 256); t.n0 = nt * 128;
    if (mode == 1) { const int n = t.n0; t.drow0 = n < F ? (n >> 7) * 256 : ((n - F) >> 7) * 256 + 128; }
    else t.drow0 = t.n0;
    return t;
}
__device__ __forceinline__ void cvt_load(const CvtTile& t, f32x4 (&v)[8]) {
    const int tid = threadIdx.x, ng = tid & 31, kg = tid >> 5;
    const int n = t.n0 + ng * 4;
    const float* s = t.src + (size_t)(t.k0 + kg * 8) * t.ldn + n;
    const bool ok = n < t.nvalid;
#pragma unroll
    for (int i = 0; i < 8; ++i) v[i] = ok ? __builtin_nontemporal_load((const f32x4*)(s + (size_t)i * t.ldn)) : (f32x4){0.f, 0.f, 0.f, 0.f};
}
__device__ __forceinline__ void cvt_pack(const f32x4 (&v)[8], char* ldsc, int ng, int kg) {
#pragma unroll
    for (int c = 0; c < 4; ++c) {
        u32x4 w;
        w.x = cvt_pk_bf16(v[0][c], v[1][c]); w.y = cvt_pk_bf16(v[2][c], v[3][c]);
        w.z = cvt_pk_bf16(v[4][c], v[5][c]); w.w = cvt_pk_bf16(v[6][c], v[7][c]);
        *(u32x4*)(ldsc + (ng * 4 + c) * 256 + ((kg ^ (ng & 15)) << 4)) = w;
    }
}
__device__ __forceinline__ void cvt_store(const CvtTile& cur, const char* ldsc, int tid) {
    const int kc = tid & 15;
#pragma unroll
    for (int i = 0; i < 4; ++i) {
        const int nr = (tid >> 4) + 32 * i;
        const u32x4 w = *(const u32x4*)(ldsc + nr * 256 + ((kc ^ ((nr >> 2) & 15)) << 4));
        const int drow = cur.perm ? in_colmap(cur.n0 + nr) : cur.drow0 + nr;
        *(u32x4*)(cur.dst + (size_t)drow * cur.K + cur.k0 + kc * 8) = w;
    }
}
__device__ __forceinline__ void cvt_load8(const CvtTile& t, f32x4 (&v)[16]) {
    const int tid = threadIdx.x, ng = tid & 31, kg = tid >> 5;
    const float* s = t.src + (size_t)(t.k0 + kg * 16) * t.ldn + t.n0 + ng * 4;
    const bool ok = t.n0 + ng * 4 < t.nvalid;
#pragma unroll
    for (int i = 0; i < 16; ++i) v[i] = ok ? __builtin_nontemporal_load((const f32x4*)(s + (size_t)i * t.ldn)) : (f32x4){0.f, 0.f, 0.f, 0.f};
}
__device__ __forceinline__ unsigned pack4_fp8(float a, float b, float c, float d) {
    int w = 0;
    w = __builtin_amdgcn_cvt_pk_fp8_f32(a, b, w, false);
    w = __builtin_amdgcn_cvt_pk_fp8_f32(c, d, w, true);
    return (unsigned)w;
}
__device__ __forceinline__ void cvt_pack8(const f32x4 (&v)[16], char* ldsc, int ng, int kg) {
#pragma unroll
    for (int c = 0; c < 4; ++c) {
        u32x4 w;
        w.x = pack4_fp8(v[0][c] * F8_WMUL, v[1][c] * F8_WMUL, v[2][c] * F8_WMUL, v[3][c] * F8_WMUL);
        w.y = pack4_fp8(v[4][c] * F8_WMUL, v[5][c] * F8_WMUL, v[6][c] * F8_WMUL, v[7][c] * F8_WMUL);
        w.z = pack4_fp8(v[8][c] * F8_WMUL, v[9][c] * F8_WMUL, v[10][c] * F8_WMUL, v[11][c] * F8_WMUL);
        w.w = pack4_fp8(v[12][c] * F8_WMUL, v[13][c] * F8_WMUL, v[14][c] * F8_WMUL, v[15][c] * F8_WMUL);
        *(u32x4*)(ldsc + (ng * 4 + c) * 256 + ((kg ^ (ng & 15)) << 4)) = w;
    }
}
__device__ __forceinline__ void cvt_store8(const CvtTile& cur, const char* ldsc, int tid) {
    const int kc = tid & 15;
    char* dst = (char*)cur.dst;
#pragma unroll
    for (int i = 0; i < 4; ++i) {
        const int nr = (tid >> 4) + 32 * i;
        const int ns = cur.perm ? nr : (nr & ~31) + perm32(nr & 31);
        const u32x4 w = *(const u32x4*)(ldsc + ns * 256 + ((kc ^ ((ns >> 2) & 15)) << 4));
        const int drow = cur.perm ? in_colmap(cur.n0 + nr) : cur.drow0 + nr;
        *(u32x4*)(dst + (size_t)drow * cur.K + cur.k0 + kc * 16) = w;
    }
}
__device__ __forceinline__ void ph_convert(const P& p, char* ldsc) {
    const int tid = threadIdx.x, ng = tid & 31, kg = tid >> 5, G_ = gridDim.x;
    {
        int u = blockIdx.x;
        if (u < CVT_B_UP) {
            CvtTile tA = cvt_decode(p, u), tB = tA;
            f32x4 vA[8], vB[8];
            cvt_load(tA, vA);
            bool hasB = u + G_ < CVT_B_UP;
            if (hasB) { tB = cvt_decode(p, u + G_); cvt_load(tB, vB); }
            int buf = 0;
            for (;;) {
                cvt_pack(vA, ldsc + buf * 32768, ng, kg);
                const CvtTile curA = tA;
                const bool hasA2 = u + 2 * G_ < CVT_B_UP;
                if (hasA2) { tA = cvt_decode(p, u + 2 * G_); cvt_load(tA, vA); }
                __syncthreads();
                cvt_store(curA, ldsc + buf * 32768, tid);
                buf ^= 1;
                if (!hasB) break;
                cvt_pack(vB, ldsc + buf * 32768, ng, kg);
                const CvtTile curB = tB;
                const bool hasB2 = u + 3 * G_ < CVT_B_UP;
                if (hasB2) { tB = cvt_decode(p, u + 3 * G_); cvt_load(tB, vB); }
                __syncthreads();
                cvt_store(curB, ldsc + buf * 32768, tid);
                buf ^= 1;
                if (!hasA2) break;
                hasB = hasB2;
                u += 2 * G_;
            }
        }
        __syncthreads();
    }
    {
        int* slot = (int*)(ldsc + 65536);
        int tick = 0;
        if (tid == 0) { slot[0] = atomicAdd(p.queue + 48, 1); slot[1] = atomicAdd(p.queue + 48, 1); tick = atomicAdd(p.queue + 48, 1); }
        __syncthreads();
        int uA = CVT_B_UP + __builtin_amdgcn_readfirstlane(slot[0]), uB = CVT_B_UP + __builtin_amdgcn_readfirstlane(slot[1]);
        if (uA < CVT_TOTAL) {
            CvtTile tA = cvt_decode(p, uA), tB = tA;
            f32x4 vA[16], vB[16];
            cvt_load8(tA, vA);
            bool hasB = uB < CVT_TOTAL;
            if (hasB) { tB = cvt_decode(p, uB); cvt_load8(tB, vB); }
            int buf = 0;
            for (;;) {
                cvt_pack8(vA, ldsc + buf * 32768, ng, kg);
                const CvtTile curA = tA;
                if (tid == 0) { slot[2] = tick; tick = atomicAdd(p.queue + 48, 1); }
                __syncthreads();
                uA = CVT_B_UP + __builtin_amdgcn_readfirstlane(slot[2]);
                const bool hasA2 = uA < CVT_TOTAL;
                if (hasA2) { tA = cvt_decode(p, uA); cvt_load8(tA, vA); }
                cvt_store8(curA, ldsc + buf * 32768, tid);
                buf ^= 1;
                if (!hasB) break;
                cvt_pack8(vB, ldsc + buf * 32768, ng, kg);
                const CvtTile curB = tB;
                if (tid == 0) { slot[3] = tick; tick = atomicAdd(p.queue + 48, 1); }
                __syncthreads();
                uB = CVT_B_UP + __builtin_amdgcn_readfirstlane(slot[3]);
                const bool hasB2 = uB < CVT_TOTAL;
                if (hasB2) { tB = cvt_decode(p, uB); cvt_load8(tB, vB); }
                cvt_store8(curB, ldsc + buf * 32768, tid);
                buf ^= 1;
                if (!hasA2) break;
                hasB = hasB2;
            }
        }
        __syncthreads();
    }
}

constexpr int G_BK = 64, G_HALF = 128, G_HTB = G_HALF * G_BK * 2  , GEMM_LDS = 8 * G_HTB;
__device__ __forceinline__ int lds_byte(int r, int c) { const int st = (r >> 4) * 2 + (c >> 5), rr = r & 15, cc = c & 31, ob = rr * 64 + cc * 2; return st * 1024 + (ob ^ (((ob >> 9) & 1) << 5)); }
__device__ __forceinline__ void stage_rc(int b, int& R, int& C) { const int st = b / 1024, sb = b % 1024, swz = sb ^ (((sb >> 9) & 1) << 5); R = (st >> 1) * 16 + swz / 64; C = (st & 1) * 32 + (swz % 64) / 2; }

struct GNoInit { __device__ __forceinline__ void operator()(f32x4 (&)[2][2][4][2], int, int, int, int) const {} };
template <bool F8, class RowOff, class KOff, class Epi, class Init = GNoInit>
__device__ __forceinline__ void gemm256(const bf16_t* A, RowOff rowoff, KOff koff, const bf16_t* Bt, int ldb, int K, char* shm, Epi epi, Init init = Init()) {
#define G_SA(b, h) (shm + ((b) * 2 + (h)) * G_HTB)
#define G_SB(b, h) (shm + (4 + (b) * 2 + (h)) * G_HTB)
#define G_STAGE_A(T_, P_, h_, kt_) do { const int _so = 2 * (int)koff(kt_); _Pragma("unroll") for (int _i = 0; _i < 2; ++_i) { const int _b = (T_) * 16 + _i * 8192; int _r, _c; stage_rc(_b, _r, _c); \
        __builtin_amdgcn_raw_ptr_buffer_load_lds(rsrcA, (__attribute__((address_space(3))) void*)((P_) + _b), 16, 2 * (int)(rowoff((h_) * G_HALF + _r) + _c), _so, 0, 0); } } while (0)
#define G_STAGE_B(T_, P_, h_, kt_) do { const int _so = 2 * ((h_) * G_HALF * ldb + (kt_) * G_BK); _Pragma("unroll") for (int _i = 0; _i < 2; ++_i) { const int _b = (T_) * 16 + _i * 8192; int _r, _c; stage_rc(_b, _r, _c); \
        __builtin_amdgcn_raw_ptr_buffer_load_lds(rsrcB, (__attribute__((address_space(3))) void*)((P_) + _b), 16, 2 * (_r * ldb + _c), _so, 0, 0); } } while (0)
#define G_LDA(dst, b, h) do { if (F8) { _Pragma("unroll") for (int m = 0; m < 4; ++m) { \
            const i32x4 lo_ = *reinterpret_cast<const i32x4*>(G_SA(b, h) + lds_byte(wr * 64 + m * 16 + fr, fq * 8)), hi_ = *reinterpret_cast<const i32x4*>(G_SA(b, h) + lds_byte(wr * 64 + m * 16 + fr, 32 + fq * 8)); \
            dst##8[m] = __builtin_shufflevector(lo_, hi_, 0, 1, 2, 3, 4, 5, 6, 7); } } \
        else { _Pragma("unroll") for (int m = 0; m < 4; ++m) _Pragma("unroll") for (int k = 0; k < 2; ++k) \
            dst[m][k] = *reinterpret_cast<const bf16x8*>(G_SA(b, h) + lds_byte(wr * 64 + m * 16 + fr, k * 32 + fq * 8)); } } while (0)
#define G_LDB(dst, b, h) do { if (F8) { _Pragma("unroll") for (int n = 0; n < 2; ++n) { \
            const i32x4 lo_ = *reinterpret_cast<const i32x4*>(G_SB(b, h) + lds_byte(wc * 32 + n * 16 + fr, fq * 8)), hi_ = *reinterpret_cast<const i32x4*>(G_SB(b, h) + lds_byte(wc * 32 + n * 16 + fr, 32 + fq * 8)); \
            dst##8[n] = __builtin_shufflevector(lo_, hi_, 0, 1, 2, 3, 4, 5, 6, 7); } } \
        else { _Pragma("unroll") for (int n = 0; n < 2; ++n) _Pragma("unroll") for (int k = 0; k < 2; ++k) \
            dst[n][k] = *reinterpret_cast<const bf16x8*>(G_SB(b, h) + lds_byte(wc * 32 + n * 16 + fr, k * 32 + fq * 8)); } } while (0)
#define G_MMA(ai, bj, At_, Bt_) do { __builtin_amdgcn_s_setprio(1); \
        if (F8) { _Pragma("unroll") for (int m = 0; m < 4; ++m) _Pragma("unroll") for (int n = 0; n < 2; ++n) \
                asm volatile("v_mfma_scale_f32_16x16x128_f8f6f4 %0, %1, %2, %0, %3, %4 op_sel_hi:[0,0,0]" : "+v"(acc[ai][bj][m][n]) : "v"(Bt_##8[n]), "v"(At_##8[m]), "v"(f8sw), "v"(f8sa)); } \
        else { _Pragma("unroll") for (int m = 0; m < 4; ++m) _Pragma("unroll") for (int n = 0; n < 2; ++n) _Pragma("unroll") for (int k = 0; k < 2; ++k) \
            acc[ai][bj][m][n] = __builtin_amdgcn_mfma_f32_16x16x32_bf16(Bt_[n][k], At_[m][k], acc[ai][bj][m][n], 0, 0, 0); } \
        __builtin_amdgcn_s_setprio(0); } while (0)
#define G_WAIT_V(n) asm volatile("s_waitcnt vmcnt(" #n ")" ::: "memory")
#define G_WAIT_L(n) asm volatile("s_waitcnt lgkmcnt(" #n ")" ::: "memory")
#define G_BAR __builtin_amdgcn_s_barrier()
#define G_SCHED __builtin_amdgcn_sched_barrier(0)
    int t0 = threadIdx.x; asm volatile("" : "+v"(t0));
    const __amdgpu_buffer_rsrc_t rsrcA = __builtin_amdgcn_make_buffer_rsrc((void*)A, 0, -1, 0x00020000), rsrcB = __builtin_amdgcn_make_buffer_rsrc((void*)Bt, 0, -1, 0x00020000);
    int wid = t0 >> 6, lane = t0 & 63, wr = wid >> 2, wc = wid & 3, fr = lane & 15, fq = lane >> 4;
    f32x4 acc[2][2][4][2] = {};
    init(acc, wr, wc, fr, fq);
    bf16x8 At[4][2], B0[2][2], B1[2][2];
    i32x8 At8[4], B08[2], B18[2];
    const int f8sw = F8_SCALE_W, f8sa = F8_SCALE_A;
    const int nt = K / G_BK;
    G_STAGE_B(t0, G_SB(0, 0), 0, 0); G_STAGE_A(t0, G_SA(0, 0), 0, 0);
    G_STAGE_B(t0, G_SB(0, 1), 1, 0); G_STAGE_A(t0, G_SA(0, 1), 1, 0);
    if (wr == 1) G_BAR;
    G_WAIT_V(4); G_BAR;
    G_STAGE_B(t0, G_SB(1, 0), 0, 1); G_STAGE_A(t0, G_SA(1, 0), 0, 1); G_STAGE_B(t0, G_SB(1, 1), 1, 1);
    G_WAIT_V(6); G_BAR;
    for (int t = 0; t < nt - 2; t += 2) {
        G_LDB(B0, 0, 0); G_SCHED; G_LDA(At, 0, 0); G_STAGE_A(t0, G_SA(1, 1), 1, t + 1);
        G_WAIT_L(8); G_BAR; G_WAIT_L(0); G_MMA(0, 0, At, B0); G_BAR; G_SCHED;
        G_LDB(B1, 0, 1); G_STAGE_B(t0, G_SB(0, 0), 0, t + 2);
        G_BAR; G_WAIT_L(0); G_MMA(0, 1, At, B1); G_BAR;
        G_LDA(At, 0, 1); G_STAGE_A(t0, G_SA(0, 0), 0, t + 2);
        G_BAR; G_WAIT_L(0); G_MMA(1, 0, At, B0); G_BAR; G_SCHED;
        G_STAGE_B(t0, G_SB(0, 1), 1, t + 2);
        G_WAIT_V(6); G_BAR; G_MMA(1, 1, At, B1); G_BAR;
        G_LDB(B0, 1, 0); G_SCHED; G_LDA(At, 1, 0); G_STAGE_A(t0, G_SA(0, 1), 1, t + 2);
        G_WAIT_L(8); G_BAR; G_WAIT_L(0); G_MMA(0, 0, At, B0); G_BAR; G_SCHED;
        G_LDB(B1, 1, 1); G_STAGE_B(t0, G_SB(1, 0), 0, t + 3);
        G_BAR; G_WAIT_L(0); G_MMA(0, 1, At, B1); G_BAR;
        G_LDA(At, 1, 1); G_STAGE_A(t0, G_SA(1, 0), 0, t + 3);
        G_BAR; G_WAIT_L(0); G_MMA(1, 0, At, B0); G_BAR; G_SCHED;
        G_STAGE_B(t0, G_SB(1, 1), 1, t + 3);
        G_WAIT_V(6); G_BAR; G_MMA(1, 1, At, B1); G_BAR;
    }
    int tz = threadIdx.x; asm volatile("" : "+v"(tz)); wid = tz >> 6; lane = tz & 63; wr = wid >> 2; wc = wid & 3; fr = lane & 15; fq = lane >> 4;
    { G_LDB(B0, 0, 0); G_WAIT_V(0); G_LDA(At, 0, 0); G_STAGE_A(tz, G_SA(1, 1), 1, nt - 1);
      G_BAR; G_WAIT_L(0); G_MMA(0, 0, At, B0); G_BAR;
      G_LDB(B1, 0, 1); G_BAR; G_WAIT_L(0); G_MMA(0, 1, At, B1); G_BAR;
      G_LDA(At, 0, 1); G_WAIT_V(4); G_BAR; G_WAIT_L(0); G_MMA(1, 0, At, B0); G_MMA(1, 1, At, B1); G_BAR; }
    { G_LDB(B0, 1, 0); G_LDA(At, 1, 0); G_WAIT_V(2); G_BAR; G_WAIT_L(0); G_MMA(0, 0, At, B0); G_BAR;
      G_LDB(B1, 1, 1); G_WAIT_V(0); G_BAR; G_WAIT_L(0); G_MMA(0, 1, At, B1); G_BAR;
      G_LDA(At, 1, 1); G_BAR; G_WAIT_L(0); G_MMA(1, 0, At, B0); G_MMA(1, 1, At, B1); G_BAR; }
    if (wr == 0) G_BAR;
    if (F8) asm volatile("s_nop 7\n\ts_nop 7\n\ts_nop 7" ::: "memory");
    epi(acc, wr, wc, fr, fq);
#undef G_SA
#undef G_SB
#undef G_STAGE_A
#undef G_STAGE_B
#undef G_LDA
#undef G_LDB
#undef G_MMA
#undef G_WAIT_V
#undef G_WAIT_L
#undef G_BAR
#undef G_SCHED
}

template <class Fn>
__device__ __forceinline__ void for_units(int nMt, int nNt, Fn fn) {
    const int nMg = (nMt + 3) >> 2, nNg = (nNt + 7) >> 3, ngroups = nMg * nNg;
    const int xcd = blockIdx.x & 7, local = blockIdx.x >> 3, nlocal = gridDim.x >> 3;
    for (int g = xcd; g < ngroups; g += 8) {
        const int mg = g / nNg, ng = g % nNg;
        for (int l = local; l < 32; l += nlocal) {
            const int mt = mg * 4 + (l & 3), nt = ng * 8 + (l >> 2);
            if (mt < nMt && nt < nNt) fn(mt, nt);
        }
    }
}

constexpr int LDS_RED_OFF = 131072 + 128;
__device__ __forceinline__ const float* head_norm_w(const P& p, int cb) {
    return cb < 8 ? p.nsa_q_norm : (cb == 12 || cb == 13) ? p.nsa_k_norm + DH : (cb == 16 || cb == 17) ? p.nsa_k_norm + 2 * DH : (cb >= 20 && cb < 28) ? p.fox_q_norm : (cb >= 28 && cb < 36) ? p.fox_k_norm : nullptr;
}
template <bool F8>
__device__ __forceinline__ void inproj_unit(const P& p, char* shm, int mt, int nt) {
    bf16_t* C = p.projb;
    float* red = (float*)(shm + LDS_RED_OFF);
    {
        const bf16_t* At = (const bf16_t*)(p.hq + (size_t)mt * 256 * D);
        const float* gw0 = head_norm_w(p, nt * 2), * gw1 = head_norm_w(p, nt * 2 + 1);
        auto epi = [=](const f32x4 (&acc)[2][2][4][2], int wr, int wc, int fr, int fq) {
                    if (gw0 || gw1) {
#pragma unroll
                        for (int ai = 0; ai < 2; ++ai)
#pragma unroll
                            for (int m = 0; m < 4; ++m)
#pragma unroll
                                for (int bj = 0; bj < 2; ++bj) {
                                    const f32x4 a = acc[ai][bj][m][0], b = acc[ai][bj][m][1];
                                    float ss = (a[0] * a[0] + a[1] * a[1]) + (a[2] * a[2] + a[3] * a[3]) + (b[0] * b[0] + b[1] * b[1]) + (b[2] * b[2] + b[3] * b[3]);
                                    ss += __shfl_xor(ss, 16); ss += __shfl_xor(ss, 32);
                                    if (fq == 0) red[((ai * 128 + wr * 64 + m * 16 + fr) * 2 + bj) * 4 + wc] = ss;
                                }
                        __syncthreads();
                    }
#pragma unroll
                    for (int ai = 0; ai < 2; ++ai)
#pragma unroll
                        for (int m = 0; m < 4; ++m) {
                            const int rl = ai * 128 + wr * 64 + m * 16 + fr, t = mt * 256 + rl;
                            bf16_t* rowp = C + (size_t)t * IN_PAD + nt * 256 + wc * 32 + fq * 4;
#pragma unroll
                            for (int bj = 0; bj < 2; ++bj) {
                                const int cb = nt * 2 + bj;
                                if (cb == 45) continue;
                                if (cb == 44) {
                                    if (wc == 0) {
#pragma unroll
                                        for (int n = 0; n < 2; ++n)
#pragma unroll
                                            for (int jx = 0; jx < 4; ++jx) {
                                                const int c = n * 16 + fq * 4 + jx; const float v = acc[ai][bj][m][n][jx];
                                                if (c < 24) p.gatesf[(size_t)t * 24 + c] = 1.f / (1.f + __expf(-(v + p.b_nsa_gate[c])));
                                                else p.logf[(size_t)t * 8 + (c - 24)] = log_sigmoid(v + p.fox_forget_bias[c - 24]);
                                            }
                                    }
                                    continue;
                                }
                                const float* gw = bj ? gw1 : gw0;
                                float rs = 1.f;
                                if (gw) { const f32x4 pr = *(const f32x4*)(red + (rl * 2 + bj) * 4); rs = rsqrtf(((pr[0] + pr[1]) + (pr[2] + pr[3])) / DH + EPS); }
#pragma unroll
                                for (int n = 0; n < 2; ++n) {
                                    f32x4 v = acc[ai][bj][m][n] * rs;
                                    if (gw) v = v * *(const f32x4*)(gw + wc * 32 + n * 16 + fq * 4);
                                    u32x2 w; w.x = cvt_pk_bf16(v[0], v[1]); w.y = cvt_pk_bf16(v[2], v[3]);
                                    *(u32x2*)(rowp + bj * 128 + n * 16) = w;
                                }
                            }
                        }
                };
        if (F8) gemm256<true>(At, [](int r) { return r * (D / 2); }, [](int kt) { return kt * G_BK; }, (const bf16_t*)(p.winq + (size_t)nt * 256 * D), D / 2, D / 2, shm, epi);
        else gemm256<false>(p.hb + (size_t)mt * 256 * D, [](int r) { return r * D; }, [](int kt) { return kt * G_BK; }, p.winT + (size_t)nt * 256 * D, D, D, shm, epi);
    }
}
__device__ __forceinline__ void ph_inproj_fast(const P& p, char* shm) {
    const int xcd = blockIdx.x & 7, local = blockIdx.x >> 3, nlocal = gridDim.x >> 3;
    for (int mg = xcd; mg < T / 1024; mg += 8) {
        for (int l = local; l < 32; l += nlocal) {
            const int j = l >> 2, nt = j < 3 ? 5 + 2 * j : j < 7 ? 15 + j : 22;
            inproj_unit<false>(p, shm, mg * 4 + (l & 3), nt);
        }
        for (int l = local; l < 60; l += nlocal) {
            const int k = l >> 2, nt = k < 5 ? k : k == 5 ? 6 : k == 6 ? 8 : k + 3;
            inproj_unit<true>(p, shm, mg * 4 + (l & 3), nt);
        }
    }
}

__device__ __forceinline__ void ph_outproj_fast(const P& p, char* shm) {
    const bf16_t* A = p.mixb; bf16_t* C = p.x1; const float* X = p.x; const float* mod = p.mod;
    for_units(T / 256, D / 256, [&](int mt, int nt) {
        const bf16_t* At = A + (size_t)mt * 256 * D;
        const float* ga = mod + (size_t)((mt * 256) / S) * 6 * D + 2 * D;
        gemm256<false>(At, [](int r) { return r * D; }, [](int kt) { return kt * G_BK; }, p.woutT + (size_t)nt * 256 * D, D, D, shm,
                [=](const f32x4 (&acc)[2][2][4][2], int wr, int wc, int fr, int fq) {
#pragma unroll
                    for (int ai = 0; ai < 2; ++ai)
#pragma unroll
                        for (int m = 0; m < 4; ++m) {
                            const size_t ro = (size_t)(mt * 256 + ai * 128 + wr * 64 + m * 16 + fr) * D;
#pragma unroll
                            for (int bj = 0; bj < 2; ++bj)
#pragma unroll
                                for (int n = 0; n < 2; ++n) {
                                    const int col = nt * 256 + bj * 128 + wc * 32 + n * 16 + fq * 4;
                                    const f32x4 xv = *(const f32x4*)(X + ro + col), gv = *(const f32x4*)(ga + col);
                                    const f32x4 r = xv + gv * acc[ai][bj][m][n];
                                    u32x2 w; w.x = cvt_pk_bf16(r[0], r[1]); w.y = cvt_pk_bf16(r[2], r[3]);
                                    *(u32x2*)(C + ro + col) = w;
                                }
                        }
                });
    });
}

constexpr int CAP = T;
__device__ __forceinline__ void ph_router_fast(const P& p, char* ldsc) {
    unsigned char* h2t = (unsigned char*)ldsc;
    float* rs_l = (float*)(ldsc + 65536);
    char* hsb = ldsc + 65792;
    float* part = (float*)hsb;
    float* logit = (float*)(hsb + 32768);
    int* destl = (int*)(hsb + 32768 + 32 * 33 * 4);
    int* hist = destl + 128;
    int tid = threadIdx.x; asm volatile("" : "+v"(tid));
    const int w = tid >> 6, lane = tid & 63;
    for (int blk = blockIdx.x; blk < T / 32; blk += gridDim.x) {
        const int t0 = blk * 32, b = t0 / S;
        __syncthreads();
#pragma unroll
        for (int q = 0; q < 4; ++q) {
            const bf16_t* xr = p.x1 + (size_t)(t0 + w * 4 + q) * D;
            float ss = 0.f;
#pragma unroll
            for (int i = 0; i < 8; ++i) { const f32x4 v = bf16x4_f(*(const u32x2*)(xr + (i * 64 + lane) * 4)); ss += v[0] * v[0] + v[1] * v[1] + v[2] * v[2] + v[3] * v[3]; }
            ss = wave_sum(ss);
            if (lane == 0) rs_l[w * 4 + q] = rsqrtf(ss / D + EPS);
        }
        __syncthreads();
        {
            const int i = lane & 31, hlf = lane >> 5;
            float* hs = (float*)hsb + w * (64 * 36);
            const int lr = lane >> 3, lc = (lane & 7) * 4;
            const float* rw = p.router_w + (size_t)(w * 256 + hlf * 128) * NE + i;
            f32x16 acc = {};
            f32x4 xv[8];
#define R_LOAD(ch_) do { _Pragma("unroll") for (int jj = 0; jj < 8; ++jj) { const int row = lr + 8 * jj; \
                xv[jj] = bf16x4_f(*(const u32x2*)(p.x1 + (size_t)(t0 + (row & 31)) * D + w * 256 + (row >> 5) * 128 + (ch_) * 32 + lc)); } } while (0)
            R_LOAD(0);
#pragma unroll 1
            for (int ch = 0; ch < 4; ++ch) {
#pragma unroll
                for (int jj = 0; jj < 8; ++jj) {
                    const int row = lr + 8 * jj, tok = row & 31, kk = w * 256 + (row >> 5) * 128 + ch * 32 + lc;
                    const float rsi = rs_l[tok];
                    const f32x4 gv = *(const f32x4*)(p.norm_moe + kk), sv = *(const f32x4*)(p.mod + (size_t)b * 6 * D + 4 * D + kk), hv = *(const f32x4*)(p.mod + (size_t)b * 6 * D + 3 * D + kk);
                    f32x4 h;
#pragma unroll
                    for (int c = 0; c < 4; ++c) h[c] = xv[jj][c] * rsi * gv[c] * (1.f + sv[c]) + hv[c];
                    *(unsigned*)(h2t + tok * D + kk) = pack4_fp8(h[0], h[1], h[2], h[3]);
                    *(f32x4*)(hs + row * 36 + lc) = h;
                }
                if (ch < 3) R_LOAD(ch + 1);
#pragma unroll
                for (int q = 0; q < 8; ++q) {
                    const f32x4 h = *(const f32x4*)(hs + (hlf * 32 + i) * 36 + q * 4);
#pragma unroll
                    for (int c = 0; c < 4; ++c) acc = __builtin_amdgcn_mfma_f32_32x32x2f32(h[c], rw[(size_t)(ch * 32 + q * 4 + c) * NE], acc, 0, 0, 0);
                }
            }
#undef R_LOAD
            __syncthreads();
            const int hi = lane >> 5;
#pragma unroll
            for (int r = 0; r < 16; ++r) part[(w * 32 + ((r & 3) + 8 * (r >> 2) + 4 * hi)) * 32 + i] = acc[r];
        }
        __syncthreads();
#pragma unroll
        for (int j = 0; j < 2; ++j) {
            const int e2 = tid + j * 512, tok = e2 >> 5, e = e2 & 31;
            float s = p.router_b[e];
#pragma unroll
            for (int ww = 0; ww < 8; ++ww) s += part[(ww * 32 + tok) * 32 + e];
            logit[tok * 33 + e] = s;
        }
        __syncthreads();
        if (tid < 32) {
            float lv[32];
#pragma unroll
            for (int e = 0; e < 32; ++e) lv[e] = logit[tid * 33 + e];
            int ti[4]; float tv[4];
#pragma unroll
            for (int k = 0; k < 4; ++k) {
                float bv = lv[0]; int bi = 0;
#pragma unroll
                for (int e = 1; e < 32; ++e) if (lv[e] > bv) { bv = lv[e]; bi = e; }
                ti[k] = bi; tv[k] = bv;
#pragma unroll
                for (int e = 0; e < 32; ++e) lv[e] = (e == bi) ? -3.4e38f : lv[e];
            }
            float ex[4], den = 0.f;
#pragma unroll
            for (int k = 0; k < 4; ++k) { ex[k] = __expf(tv[k] - tv[0]); den += ex[k]; }
            const float inv = 1.f / den;
            int lrank[4];
            hist[tid] = 0;
#pragma unroll
            for (int k = 0; k < 4; ++k) lrank[k] = atomicAdd(&hist[ti[k]], 1);
            const int mine = hist[tid];
            hist[32 + tid] = mine > 0 ? atomicAdd(p.cnt + tid * 64, mine) : 0;
#pragma unroll
            for (int k = 0; k < 4; ++k) {
                const int d = ti[k] * CAP + hist[32 + ti[k]] + lrank[k];
                destl[tid * 4 + k] = d;
                p.row_a[d] = (t0 + tid) * 4 + k; p.row_w[d] = ex[k] * inv;
            }
        }
        __syncthreads();
#pragma unroll 4
        for (int a = w; a < 128; a += 8) {
            const unsigned char* src = h2t + (a >> 2) * D;
            unsigned char* dst = p.xgq + (size_t)destl[a] * D;
#pragma unroll
            for (int jj = 0; jj < 2; ++jj) *(u32x4*)(dst + (jj * 64 + lane) * 16) = *(const u32x4*)(src + (jj * 64 + lane) * 16);
        }
    }
}

constexpr int MAXTILES = 160;
constexpr int LDS_TILE_TAB = 131072 + 64;
__device__ __forceinline__ int build_tile_table(const P& p, char* shm) {
    int* tab = (int*)(shm + LDS_TILE_TAB);
    int* cs = (int*)(shm + LDS_TILE_TAB + 1024);
    int tid = threadIdx.x; asm volatile("" : "+v"(tid));
    __syncthreads();
    int nt = 0;
    if (tid < NE) { nt = (p.cnt[tid * 64] + 255) >> 8; cs[tid] = nt; }
    __syncthreads();
    if (tid < NE) {
        int base = 0;
#pragma unroll
        for (int e = 0; e < NE; ++e) base += e < tid ? cs[e] : 0;
        for (int jt = 0; jt < nt; ++jt) tab[1 + base + jt] = (tid << 8) | jt;
        if (tid == NE - 1) tab[0] = base + nt;
    }
    __syncthreads();
    return __builtin_amdgcn_readfirstlane(tab[0]);
}

__device__ __forceinline__ void ph_up_fast(const P& p, char* shm) {
    const int ntiles = build_tile_table(p, shm);
    const int* tab = (const int*)(shm + LDS_TILE_TAB) + 1;
    for_units(ntiles, 16, [&](int mt, int nt) {
        const int te = __builtin_amdgcn_readfirstlane(tab[mt]), e = te >> 8;
        const size_t row0 = (size_t)e * CAP + (size_t)(te & 255) * 256;
        const bf16_t* At = (const bf16_t*)(p.xgq + row0 * D);
        const float* bu = p.b_up + (size_t)e * 2 * F + nt * 128;
        unsigned char* C = p.actq + row0 * F + nt * 128;
        gemm256<true>(At, [](int r) { return r * (D / 2); }, [](int kt) { return kt * G_BK; }, (const bf16_t*)(p.wupq + ((size_t)e * 2 * F + (size_t)nt * 256) * D), D / 2, D / 2, shm,
                [=](const f32x4 (&acc)[2][2][4][2], int wr, int wc, int fr, int fq) {
                    const int col = wc * 32 + fq * 8;
#pragma unroll
                    for (int ai = 0; ai < 2; ++ai)
#pragma unroll
                        for (int m = 0; m < 4; ++m) {
                            float o[8];
#pragma unroll
                            for (int n = 0; n < 2; ++n) {
                                const f32x4 g4 = acc[ai][0][m][n], l4 = acc[ai][1][m][n];
#pragma unroll
                                for (int j = 0; j < 4; ++j) {
                                    const float gl = fminf(g4[j], 7.f), li = fminf(fmaxf(l4[j], -7.f), 7.f);
                                    o[n * 4 + j] = gl * __builtin_amdgcn_rcpf(1.f + __expf(-1.702f * gl)) * (li + 1.f);
                                }
                            }
                            u32x2 wv; wv.x = pack4_fp8(o[0], o[1], o[2], o[3]); wv.y = pack4_fp8(o[4], o[5], o[6], o[7]);
                            *(u32x2*)(C + (size_t)(ai * 128 + wr * 64 + m * 16 + fr) * F + col) = wv;
                        }
                },
                [=](f32x4 (&acc)[2][2][4][2], int, int wc, int, int fq) {
                    const int col = wc * 32 + fq * 8;
#pragma unroll
                    for (int n = 0; n < 2; ++n) {
                        const f32x4 bg = *(const f32x4*)(bu + col + 4 * n), bl = *(const f32x4*)(bu + F + col + 4 * n);
#pragma unroll
                        for (int ai = 0; ai < 2; ++ai)
#pragma unroll
                            for (int m = 0; m < 4; ++m) { acc[ai][0][m][n] = bg; acc[ai][1][m][n] = bl; }
                    }
                });
    });
}

__device__ __forceinline__ void ph_down_fast(const P& p, char* shm) {
    const int ntiles = __builtin_amdgcn_readfirstlane(*(const int*)(shm + LDS_TILE_TAB));
    const int* tab = (const int*)(shm + LDS_TILE_TAB) + 1;
    for_units(ntiles, 8, [&](int mt, int nt) {
        const int te = __builtin_amdgcn_readfirstlane(tab[mt]), e = te >> 8;
        const size_t row0 = (size_t)e * CAP + (size_t)(te & 255) * 256;
        const int nvalid = p.cnt[e * 64] - (te & 255) * 256;
        const bf16_t* At = (const bf16_t*)(p.actq + row0 * F);
        const float* bd = p.b_down + (size_t)e * D + nt * 256;
        const int* ra = p.row_a + row0; const float* rwt = p.row_w + row0;
        unsigned char* Y = p.yq + nt * 256;
        gemm256<true>(At, [](int r) { return r * (F / 2); }, [](int kt) { return kt * G_BK; }, (const bf16_t*)(p.wdnq + ((size_t)e * D + (size_t)nt * 256) * F), F / 2, F / 2, shm,
                [=](const f32x4 (&acc)[2][2][4][2], int wr, int wc, int fr, int fq) {
#pragma unroll
                    for (int ai = 0; ai < 2; ++ai)
#pragma unroll
                        for (int m = 0; m < 4; ++m) {
                            const int row = ai * 128 + wr * 64 + m * 16 + fr;
                            if (row < nvalid) {
                                const int a = ra[row];
                                const float wgt = rwt[row];
                                unsigned char* yr = Y + (size_t)a * D;
#pragma unroll
                                for (int bj = 0; bj < 2; ++bj) {
                                    const int col = bj * 128 + wc * 32 + fq * 8;
                                    const f32x4 v0 = acc[ai][bj][m][0] * wgt, v1 = acc[ai][bj][m][1] * wgt;
                                    f32x4 s0 = v0 * 16.f, s1 = v1 * 16.f;
#pragma unroll
                                    for (int j = 0; j < 4; ++j) { s0[j] = __builtin_amdgcn_fmed3f(s0[j], -448.f, 448.f); s1[j] = __builtin_amdgcn_fmed3f(s1[j], -448.f, 448.f); }
                                    u32x2 wv; wv.x = pack4_fp8(s0[0], s0[1], s0[2], s0[3]); wv.y = pack4_fp8(s1[0], s1[1], s1[2], s1[3]);
                                    *(u32x2*)(yr + col) = wv;
                                }
                            }
                        }
                },
                [=](f32x4 (&acc)[2][2][4][2], int, int wc, int, int fq) {
#pragma unroll
                    for (int bj = 0; bj < 2; ++bj)
#pragma unroll
                        for (int n = 0; n < 2; ++n) {
                            const f32x4 b = *(const f32x4*)(bd + bj * 128 + wc * 32 + fq * 8 + 4 * n);
#pragma unroll
                            for (int ai = 0; ai < 2; ++ai)
#pragma unroll
                                for (int m = 0; m < 4; ++m) acc[ai][bj][m][n] = b;
                        }
                });
    });
}

__device__ __forceinline__ void ph_final_fast(const P& p) {
    constexpr size_t NV = (size_t)T * D / 4;
    const size_t stride = (size_t)gridDim.x * NTHR;
    int tid = threadIdx.x; asm volatile("" : "+v"(tid));
    for (size_t i0 = (size_t)blockIdx.x * NTHR + tid; i0 < NV; i0 += 4 * stride) {
        unsigned yv[4][4]; f32x4 xv[4], gm[4];
#pragma unroll
        for (int u = 0; u < 4; ++u) {
            size_t i = i0 + u * stride; i = i < NV ? i : NV - 1;
            const size_t t = i / (D / 4); const int n = (int)(i % (D / 4)) * 4;
#pragma unroll
            for (int k = 0; k < 4; ++k) yv[u][k] = *(const unsigned*)(p.yq + (t * 4 + k) * D + n);
            xv[u] = bf16x4_f(*(const u32x2*)(p.x1 + t * D + n));
            gm[u] = *(const f32x4*)(p.mod + (t / S) * 6 * D + 5 * D + n);
        }
#pragma unroll
        for (int u = 0; u < 4; ++u) {
            const size_t i = i0 + u * stride;
            f32x4 s = {0.f, 0.f, 0.f, 0.f};
#pragma unroll
            for (int k = 0; k < 4; ++k) { const f32x2 lo = __builtin_amdgcn_cvt_pk_f32_fp8((int)yv[u][k], false), hi = __builtin_amdgcn_cvt_pk_f32_fp8((int)yv[u][k], true); s[0] += lo[0]; s[1] += lo[1]; s[2] += hi[0]; s[3] += hi[1]; }
            if (i < NV) *(f32x4*)(p.out + i * 4) = xv[u] + gm[u] * s * 0.0625f;
        }
    }
}

typedef short s16x4 __attribute__((ext_vector_type(4)));
constexpr int A_SHM = 64 * 128 * 2;
constexpr int A_OFF_V = 0, A_OFF_K = 2 * A_SHM, A_OFF_WS = 4 * A_SHM, A_OFF_TBL = A_OFF_WS + 8 * 64 * 4, A_OFF_CK = A_OFF_TBL + 8 * 128 * 4, A_OFF_Q = A_OFF_CK + 2 * 64 * 4, A_OFF_SEL = A_OFF_Q + 256, A_OFF_CUM = A_OFF_SEL + 256;
constexpr float LOG2E = 1.4426950408889634f;
#define A_KSWZ(row, colB) ((row) * 256 + ((colB) ^ (((row) & 15) << 4)))
__device__ __forceinline__ int a_v_st(int k, int c) { const int kk = (k & ~0xC) | ((k & 4) << 1) | ((k & 8) >> 1); return ((kk >> 3) * 4 + (c >> 5)) * 512 + ((kk & 7) * 32 + (c & 31)) * 2; }
__device__ __forceinline__ int a_v_rd_base(int lane) { return ((lane & 3) << 3) | (((lane >> 2) & 3) << 6) | (((lane >> 4) & 1) << 5) | (((lane >> 5) & 1) << 8); }
__device__ __forceinline__ int a_crow(int r, int hi) { return (r & 3) + 8 * (r >> 2) + 4 * hi; }

__device__ __forceinline__ void a_qkt(f32x16& p0, f32x16& p1, const char* kbase, int r32, int hi, const bf16x8* qr) {
    p0 = f32x16{}; p1 = f32x16{};
#pragma unroll
    for (int d0 = 0; d0 < 8; ++d0) {
        const char* a = kbase + A_KSWZ(r32, (d0 * 16 + hi * 8) * 2);
        const bf16x8 b0 = *reinterpret_cast<const bf16x8*>(a);
        const bf16x8 b1 = *reinterpret_cast<const bf16x8*>(a + 32 * 256);
        p0 = __builtin_amdgcn_mfma_f32_32x32x16_bf16(b0, qr[d0], p0, 0, 0, 0);
        p1 = __builtin_amdgcn_mfma_f32_32x32x16_bf16(b1, qr[d0], p1, 0, 0, 0);
    }
}
__device__ __forceinline__ void a_pv(f32x16* o, int vb, bf16x8 pa0, bf16x8 pa1, bf16x8 pa2, bf16x8 pa3) {
#define A_TRRD(dst, off) asm volatile("ds_read_b64_tr_b16 %0, %1 offset:%2" : "=&v"(dst) : "v"(vb), "i"(off) : "memory")
#define A_RD8(S_, d0) do { constexpr int b_ = (d0) * 512; \
        A_TRRD(S_##l0, b_); A_TRRD(S_##h0, b_ + 2048); A_TRRD(S_##l1, b_ + 4096); A_TRRD(S_##h1, b_ + 6144); A_TRRD(S_##l2, b_ + 8192); A_TRRD(S_##h2, b_ + 10240); A_TRRD(S_##l3, b_ + 12288); A_TRRD(S_##h3, b_ + 14336); } while (0)
#define A_MM4(S_, d0) do { \
        o[d0] = __builtin_amdgcn_mfma_f32_32x32x16_bf16(pa0, (bf16x8){S_##l0[0], S_##l0[1], S_##l0[2], S_##l0[3], S_##h0[0], S_##h0[1], S_##h0[2], S_##h0[3]}, o[d0], 0, 0, 0); \
        o[d0] = __builtin_amdgcn_mfma_f32_32x32x16_bf16(pa1, (bf16x8){S_##l1[0], S_##l1[1], S_##l1[2], S_##l1[3], S_##h1[0], S_##h1[1], S_##h1[2], S_##h1[3]}, o[d0], 0, 0, 0); \
        o[d0] = __builtin_amdgcn_mfma_f32_32x32x16_bf16(pa2, (bf16x8){S_##l2[0], S_##l2[1], S_##l2[2], S_##l2[3], S_##h2[0], S_##h2[1], S_##h2[2], S_##h2[3]}, o[d0], 0, 0, 0); \
        o[d0] = __builtin_amdgcn_mfma_f32_32x32x16_bf16(pa3, (bf16x8){S_##l3[0], S_##l3[1], S_##l3[2], S_##l3[3], S_##h3[0], S_##h3[1], S_##h3[2], S_##h3[3]}, o[d0], 0, 0, 0); } while (0)
    s16x4 xl0, xl1, xl2, xl3, xh0, xh1, xh2, xh3, yl0, yl1, yl2, yl3, yh0, yh1, yh2, yh3;
    A_RD8(x, 0);
    A_RD8(y, 1);
    asm volatile("s_waitcnt lgkmcnt(8)" ::: "memory"); __builtin_amdgcn_sched_barrier(0);
    A_MM4(x, 0);
    __builtin_amdgcn_sched_barrier(0);
    A_RD8(x, 2);
    asm volatile("s_waitcnt lgkmcnt(8)" ::: "memory"); __builtin_amdgcn_sched_barrier(0);
    A_MM4(y, 1);
    __builtin_amdgcn_sched_barrier(0);
    A_RD8(y, 3);
    asm volatile("s_waitcnt lgkmcnt(8)" ::: "memory"); __builtin_amdgcn_sched_barrier(0);
    A_MM4(x, 2);
    asm volatile("s_waitcnt lgkmcnt(0)" ::: "memory"); __builtin_amdgcn_sched_barrier(0);
    A_MM4(y, 3);
#undef A_MM4
#undef A_RD8
#undef A_TRRD
}

__device__ __forceinline__ void a_build_tbl(const P& p, char* lds) {
    float* tbl = (float*)(lds + A_OFF_TBL);
    for (int i = threadIdx.x; i < 8 * 128; i += NTHR) { const int h = i >> 7, d = i & 127; tbl[i] = p.rel_bias[BUCKET[d] * 8 + h] * LOG2E; }
}

template <int MODE>
__device__ __forceinline__ void attn_unit(const P& p, int b, int hh, int qb, char* lds) {
    int tid = threadIdx.x; asm volatile("" : "+v"(tid));
    const int wid = __builtin_amdgcn_readfirstlane(tid >> 6), lane = tid & 63, r32 = lane & 31, hi = lane >> 5;
    int h, q0, qlo, qoff, koff, voff, j_lo, j_hi;
    if (MODE == 2) { h = hh; q0 = qb * 256; qlo = q0 + 32 * wid; qoff = OFF_QF + h * DH; koff = OFF_KF + h * DH; voff = OFF_VF + h * DH; j_lo = 0; j_hi = 4 * qb + 4; }
    else { h = hh * R + (wid >> 1); q0 = qb * 64; qlo = q0 + 32 * (wid & 1); qoff = OFF_QN + h * DH;
           koff = (MODE == 0 ? OFF_KW : OFF_KS) + hh * DH; voff = (MODE == 0 ? OFF_VW : OFF_VS) + hh * DH;
           j_lo = (MODE == 0 && q0 > 511) ? ((q0 - 511) >> 6) : 0; j_hi = qb + 1; }
    const int NT = j_hi - j_lo;
    const bf16_t* base = p.projb + (size_t)b * S * IN_PAD;
    char* V_lds = lds + A_OFF_V; char* K_lds = lds + A_OFF_K;
    float* ws = (float*)(lds + A_OFF_WS) + wid * 64; float* li_l = ws; float* al_l = ws + 32;
    const float* tbl = (const float*)(lds + A_OFF_TBL) + h * 128;
    float* cum_l = (float*)(lds + A_OFF_CUM);
    bf16x8 qr[8];
    {
        const bf16_t* qrow = base + (size_t)(qlo + r32) * IN_PAD + qoff + hi * 8;
#pragma unroll
        for (int d0 = 0; d0 < 8; ++d0) qr[d0] = *reinterpret_cast<const bf16x8*>(qrow + d0 * 16);
    }
    unsigned selm = 0xffffffffu;
    const float c31 = (MODE == 2) ? 0.f : tbl[127];
    constexpr float C2 = LOG2E * SCALE;
    constexpr float THR2 = 8.f * LOG2E;
    constexpr unsigned WMASK = MODE == 0 ? 512u : 0x80000000u;
    const int sr = tid >> 4, sc = (tid & 15) * 8;
    const int kws = A_KSWZ(sr, sc * 2), vst0 = a_v_st(sr, sc), vst1 = a_v_st(32 + sr, sc);
    const int vb0 = (int)(uintptr_t)V_lds + a_v_rd_base(lane);
    float m_reg = -1e30f, l_reg = 0.f; f32x16 o[4] = {};
    bf16x8 st_k0, st_k1, st_v0, st_v1;
#define A_LOAD(kb_) do { const bf16_t* r0_ = base + (size_t)((kb_) + sr) * IN_PAD + sc; const bf16_t* r1_ = r0_ + (size_t)32 * IN_PAD; \
        st_k0 = *reinterpret_cast<const bf16x8*>(r0_ + koff); st_k1 = *reinterpret_cast<const bf16x8*>(r1_ + koff); \
        st_v0 = *reinterpret_cast<const bf16x8*>(r0_ + voff); st_v1 = *reinterpret_cast<const bf16x8*>(r1_ + voff); \
        } while (0)
#define A_WRITE(bf_) do { *(bf16x8*)(K_lds + (bf_) * A_SHM + kws) = st_k0; *(bf16x8*)(K_lds + (bf_) * A_SHM + kws + 32 * 256) = st_k1; \
        *(bf16x8*)(V_lds + (bf_) * A_SHM + vst0) = st_v0; *(bf16x8*)(V_lds + (bf_) * A_SHM + vst1) = st_v1; \
        } while (0)
    __syncthreads();
    A_LOAD(j_lo * 64);
    float v4[4] = {0.f, 0.f, 0.f, 0.f};
    if (MODE == 2) {
        const int nkeys = q0 + 256;
        const float* lf = p.logf + (size_t)b * S * 8 + h;
#pragma unroll
        for (int i = 0; i < 4; ++i) { const int sidx = tid * 4 + i; v4[i] = sidx < nkeys ? lf[(size_t)sidx * 8] : 0.f; }
    }
    A_WRITE(0);
    if (MODE == 2) {
        float run = 0.f;
#pragma unroll
        for (int i = 0; i < 4; ++i) { run += v4[i]; v4[i] = run; }
        float inc = run;
#pragma unroll
        for (int o = 1; o < 64; o <<= 1) { const float nb = __shfl_up(inc, o); if (lane >= o) inc += nb; }
        float* wtot = ws + 48;
        float* wsum = (float*)(lds + A_OFF_Q) + 16;
        (void)wtot;
        if (lane == 63) wsum[wid] = inc;
        __syncthreads();
        float basew = 0.f;
#pragma unroll
        for (int i = 0; i < 8; ++i) basew += i < wid ? wsum[i] : 0.f;
        const float excl = basew + inc - run;
#pragma unroll
        for (int i = 0; i < 4; ++i) cum_l[tid * 4 + i] = -(excl + v4[i]) * LOG2E;
    }
    __syncthreads();
    if (MODE == 1) selm = ((const unsigned*)(lds + A_OFF_SEL))[qlo - q0 + r32];
    for (int t = 0; t < NT; ++t) {
        const int bf = t & 1, kb = (j_lo + t) * 64;
        if (t + 1 < NT) A_LOAD(kb + 64);
        const bool act = kb <= qlo + 31 && (MODE != 0 || kb + 63 >= qlo - 511);
        if (act) {
            f32x16 p0, p1;
            a_qkt(p0, p1, K_lds + bf * A_SHM, r32, hi, qr);
            const int dq = qlo + r32 - kb - 4 * hi;
            if (MODE == 2) {
                const float* ck = cum_l + kb + 4 * hi;
#pragma unroll
                for (int i = 0; i < 4; ++i) {
                    const f32x4 c0 = *(const f32x4*)(ck + 8 * i), c1 = *(const f32x4*)(ck + 32 + 8 * i);
#pragma unroll
                    for (int j = 0; j < 4; ++j) { p0[4 * i + j] = fmaf(p0[4 * i + j], C2, c0[j]); p1[4 * i + j] = fmaf(p1[4 * i + j], C2, c1[j]); }
                }
            } else {
                const bool far = qlo - (kb + 63) >= 113;
                if (far) {
                    const float cf = (MODE == 1 && !((selm >> (j_lo + t)) & 1u)) ? -__builtin_inff() : c31;
#pragma unroll
                    for (int r = 0; r < 16; ++r) { p0[r] = fmaf(p0[r], C2, cf); p1[r] = fmaf(p1[r], C2, cf); }
                } else {
#pragma unroll
                    for (int r = 0; r < 16; ++r) {
                        const int c = (r & 3) + 8 * (r >> 2);
                        const int d0i = min(max(dq - c, 0), 127), d1i = min(max(dq - c - 32, 0), 127);
                        p0[r] = fmaf(p0[r], C2, tbl[d0i]); p1[r] = fmaf(p1[r], C2, tbl[d1i]);
                    }
                }
            }
            const bool needmask = (kb + 63 > qlo) || (MODE == 0 && (qlo + 31 - kb) >= 512);
            if (needmask) {
                const float NEG = -__builtin_inff();
#pragma unroll
                for (int r = 0; r < 16; ++r) {
                    const int c = (r & 3) + 8 * (r >> 2);
                    if ((unsigned)(dq - c) >= WMASK) p0[r] = NEG;
                    if ((unsigned)(dq - c - 32) >= WMASK) p1[r] = NEG;
                }
            }
            if (MODE == 1 && !(qlo - (kb + 63) >= 113)) {
                if (!((selm >> (j_lo + t)) & 1u)) {
                    const float NEG = -__builtin_inff();
#pragma unroll
                    for (int r = 0; r < 16; ++r) { p0[r] = NEG; p1[r] = NEG; }
                }
            }
            float pmax = p0[0];
#pragma unroll
            for (int r = 1; r < 16; ++r) pmax = fmaxf(pmax, p0[r]);
#pragma unroll
            for (int r = 0; r < 16; ++r) pmax = fmaxf(pmax, p1[r]);
            { auto rr = __builtin_amdgcn_permlane32_swap(__float_as_uint(pmax), __float_as_uint(pmax), false, false);
              pmax = fmaxf(__uint_as_float(rr[0]), __uint_as_float(rr[1])); }
            float mn, alpha;
            if (__all(pmax - m_reg <= THR2)) { mn = m_reg; alpha = 1.f; }
            else { mn = fmaxf(m_reg, pmax); alpha = __builtin_amdgcn_exp2f(m_reg - mn); m_reg = mn; }
#pragma unroll
            for (int r = 0; r < 16; ++r) { p0[r] = __builtin_amdgcn_exp2f(p0[r] - mn); p1[r] = __builtin_amdgcn_exp2f(p1[r] - mn); }
            float ps = 0.f;
#pragma unroll
            for (int r = 0; r < 16; ++r) ps += p0[r];
#pragma unroll
            for (int r = 0; r < 16; ++r) ps += p1[r];
            { auto rr = __builtin_amdgcn_permlane32_swap(__float_as_uint(ps), __float_as_uint(ps), false, false);
              ps = __uint_as_float(rr[0]) + __uint_as_float(rr[1]); }
            l_reg = l_reg * alpha + ps;
            bf16x8 pa0, pa1, pa2, pa3;
#define A_PK4(P_, B_, OUT) do { unsigned a0 = cvt_pk_bf16(P_[B_ + 0], P_[B_ + 1]), a1 = cvt_pk_bf16(P_[B_ + 2], P_[B_ + 3]); \
        unsigned b0 = cvt_pk_bf16(P_[B_ + 4], P_[B_ + 5]), b1 = cvt_pk_bf16(P_[B_ + 6], P_[B_ + 7]); \
        auto r0 = __builtin_amdgcn_permlane32_swap(a0, b0, false, false); auto r1 = __builtin_amdgcn_permlane32_swap(a1, b1, false, false); \
        u32x4 w_ = {r0[0], r1[0], r0[1], r1[1]}; OUT = *reinterpret_cast<bf16x8*>(&w_); } while (0)
            A_PK4(p0, 0, pa0); A_PK4(p0, 8, pa1); A_PK4(p1, 0, pa2); A_PK4(p1, 8, pa3);
#undef A_PK4
            if (__any(alpha < 1.f)) {
                if (hi == 0) al_l[r32] = alpha;
                asm volatile("s_waitcnt lgkmcnt(0)" ::: "memory");
#pragma unroll
                for (int r = 0; r < 16; ++r) { const float a = al_l[a_crow(r, hi)];
#pragma unroll
                    for (int d_ = 0; d_ < 4; ++d_) o[d_][r] *= a; }
            }
            a_pv(o, vb0 + bf * A_SHM, pa0, pa1, pa2, pa3);
        }
        if (t + 1 < NT) A_WRITE(bf ^ 1);
        __syncthreads();
    }
#undef A_LOAD
#undef A_WRITE
    if (hi == 0) li_l[r32] = l_reg;
    asm volatile("s_waitcnt lgkmcnt(0)" ::: "memory");
    bf16_t* obuf = (MODE == 0 ? p.owinb : MODE == 1 ? p.oslcb : p.ofoxb) + (size_t)(b * S + qlo) * 1024 + h * DH;
#pragma unroll
    for (int r = 0; r < 16; ++r) {
        const int orow = a_crow(r, hi);
        const float rl = __builtin_amdgcn_rcpf(li_l[orow]);
#pragma unroll
        for (int d0 = 0; d0 < 4; ++d0) {
            const float v = o[d0][r] * rl;
            const float vn = __shfl_xor(v, 1);
            if ((r32 & 1) == 0) *(unsigned*)(obuf + (size_t)orow * 1024 + d0 * 32 + r32) = cvt_pk_bf16(v, vn);
        }
    }
}

__device__ __forceinline__ int next_unit(int* ctr, char* lds) {
    int* slot = (int*)(lds + A_OFF_Q);
    __syncthreads();
    if (threadIdx.x == 0) *slot = atomicAdd(ctr, 1);
    __syncthreads();
    return __builtin_amdgcn_readfirstlane(*slot);
}
constexpr int A_OFF_SLAB = 81920;
__device__ __forceinline__ void cmpattn_unit(const P& p, int b, int g, int qb, char* lds) {
    int tid = threadIdx.x; asm volatile("" : "+v"(tid));
    const int wid = __builtin_amdgcn_readfirstlane(tid >> 6), lane = tid & 63, r32 = lane & 31, hi = lane >> 5;
    const int hl = wid >> 1, h = g * R + hl, q0 = qb * 64, qlo = q0 + 32 * (wid & 1), tq = qlo + r32;
    const int nk = min(NCMP, 4 * qb + 3), NT = (nk + 63) >> 6;
    char* V_lds = lds + A_OFF_V; char* K_lds = lds + A_OFF_K;
    float* ws = (float*)(lds + A_OFF_WS) + wid * 64; float* li_l = ws;
    const float* tbl = (const float*)(lds + A_OFF_TBL) + h * 128;
    float* slab = (float*)(lds + A_OFF_SLAB);
    bf16x8 qr[8];
    {
        const bf16_t* qrow = p.projb + (size_t)(b * S + tq) * IN_PAD + OFF_QN + h * DH + hi * 8;
#pragma unroll
        for (int d0 = 0; d0 < 8; ++d0) qr[d0] = *reinterpret_cast<const bf16x8*>(qrow + d0 * 16);
    }
    const int sr = tid >> 4, sc = (tid & 15) * 8;
    const int kws = A_KSWZ(sr, sc * 2), vst0 = a_v_st(sr, sc), vst1 = a_v_st(32 + sr, sc);
    __syncthreads();
    {
        f32x4* z = (f32x4*)slab;
#pragma unroll
        for (int i = 0; i < 4; ++i) z[tid + i * NTHR] = (f32x4){0.f, 0.f, 0.f, 0.f};
        bf16x8 sk0[2], sk1[2], sv0[2], sv1[2];
#pragma unroll
        for (int t = 0; t < 2; ++t) {
            const int n0 = min(t * 64 + sr, NCMP - 1), n1 = min(t * 64 + 32 + sr, NCMP - 1);
            const bf16_t* k0p = p.cmpb + ((size_t)((b * NCMP + n0) * G + g)) * DH + sc;
            const bf16_t* k1p = p.cmpb + ((size_t)((b * NCMP + n1) * G + g)) * DH + sc;
            sk0[t] = *reinterpret_cast<const bf16x8*>(k0p); sk1[t] = *reinterpret_cast<const bf16x8*>(k1p);
            sv0[t] = *reinterpret_cast<const bf16x8*>(k0p + (size_t)1024 * DH); sv1[t] = *reinterpret_cast<const bf16x8*>(k1p + (size_t)1024 * DH);
        }
#pragma unroll
        for (int t = 0; t < 2; ++t) {
            if (t < NT) {
                *(bf16x8*)(K_lds + t * A_SHM + kws) = sk0[t]; *(bf16x8*)(K_lds + t * A_SHM + kws + 32 * 256) = sk1[t];
                *(bf16x8*)(V_lds + t * A_SHM + vst0) = sv0[t]; *(bf16x8*)(V_lds + t * A_SHM + vst1) = sv1[t];
            }
        }
    }
    __syncthreads();
    constexpr float C2 = LOG2E * SCALE;
    const float c31 = tbl[127];
    const float NEG = -__builtin_inff();
    f32x16 pp[4];
#pragma unroll
    for (int t = 0; t < 2; ++t) {
        if (t < NT) {
            a_qkt(pp[2 * t], pp[2 * t + 1], K_lds + t * A_SHM, r32, hi, qr);
#pragma unroll
            for (int a = 0; a < 2; ++a) {
                const int nb = t * 64 + a * 32;
                const int dq = tq - 31 - 16 * (nb + 4 * hi);
                const bool far = (qlo - 31 - 16 * (nb + 31)) >= 113;
                if (far) {
#pragma unroll
                    for (int r = 0; r < 16; ++r) pp[2 * t + a][r] = fmaf(pp[2 * t + a][r], C2, c31);
                } else {
#pragma unroll
                    for (int r = 0; r < 16; ++r) {
                        const int c = (r & 3) + 8 * (r >> 2);
                        const int d = dq - 16 * c;
                        const float x = fmaf(pp[2 * t + a][r], C2, tbl[min(max(d, 0), 127)]);
                        pp[2 * t + a][r] = d < 0 ? NEG : x;
                    }
                }
            }
        } else {
#pragma unroll
            for (int r = 0; r < 16; ++r) { pp[2 * t][r] = NEG; pp[2 * t + 1][r] = NEG; }
        }
    }
    float pmax = NEG;
#pragma unroll
    for (int a = 0; a < 4; ++a)
#pragma unroll
        for (int r = 0; r < 16; ++r) pmax = fmaxf(pmax, pp[a][r]);
    { auto rr = __builtin_amdgcn_permlane32_swap(__float_as_uint(pmax), __float_as_uint(pmax), false, false);
      pmax = fmaxf(__uint_as_float(rr[0]), __uint_as_float(rr[1])); }
    const float mn = fmaxf(pmax, -1e30f);
    float ps = 0.f;
#pragma unroll
    for (int a = 0; a < 4; ++a)
#pragma unroll
        for (int r = 0; r < 16; ++r) { pp[a][r] = __builtin_amdgcn_exp2f(pp[a][r] - mn); ps += pp[a][r]; }
    { auto rr = __builtin_amdgcn_permlane32_swap(__float_as_uint(ps), __float_as_uint(ps), false, false);
      ps = __uint_as_float(rr[0]) + __uint_as_float(rr[1]); }
    const float inv_l = ps > 0.f ? __builtin_amdgcn_rcpf(ps) : 0.f;
    {
        float* sl = slab + (size_t)(hl * 32) * 64 + (32 * (wid & 1) + r32);
#pragma unroll
        for (int a = 0; a < 4; ++a)
#pragma unroll
            for (int i = 0; i < 4; ++i) {
                const int j = 8 * a + 2 * i + hi;
                const float A = ((pp[a][4 * i] + pp[a][4 * i + 1]) + (pp[a][4 * i + 2] + pp[a][4 * i + 3])) * inv_l;
                const float L = pp[a][4 * i + 3] * inv_l;
                atomicAdd(sl + j * 64, A);
                if (j < 31) atomicAdd(sl + (j + 1) * 64, L);
            }
    }
    f32x16 o[4] = {};
    const int vb0 = (int)(uintptr_t)V_lds + a_v_rd_base(lane);
#define C_PK4(P_, B_, OUT) do { unsigned a0 = cvt_pk_bf16(P_[B_ + 0], P_[B_ + 1]), a1 = cvt_pk_bf16(P_[B_ + 2], P_[B_ + 3]); \
        unsigned b0 = cvt_pk_bf16(P_[B_ + 4], P_[B_ + 5]), b1 = cvt_pk_bf16(P_[B_ + 6], P_[B_ + 7]); \
        auto r0 = __builtin_amdgcn_permlane32_swap(a0, b0, false, false); auto r1 = __builtin_amdgcn_permlane32_swap(a1, b1, false, false); \
        u32x4 w_ = {r0[0], r1[0], r0[1], r1[1]}; OUT = *reinterpret_cast<bf16x8*>(&w_); } while (0)
#pragma unroll
    for (int t = 0; t < 2; ++t) {
        if (t < NT) {
            bf16x8 pa0, pa1, pa2, pa3;
            C_PK4(pp[2 * t], 0, pa0); C_PK4(pp[2 * t], 8, pa1); C_PK4(pp[2 * t + 1], 0, pa2); C_PK4(pp[2 * t + 1], 8, pa3);
            a_pv(o, vb0 + t * A_SHM, pa0, pa1, pa2, pa3);
        }
    }
#undef C_PK4
    if (hi == 0) li_l[r32] = inv_l;
    asm volatile("s_waitcnt lgkmcnt(0)" ::: "memory");
    bf16_t* obuf = p.ocmpb + (size_t)(b * S + qlo) * 1024 + h * DH;
#pragma unroll
    for (int r = 0; r < 16; ++r) {
        const int orow = a_crow(r, hi);
        const float rl = li_l[orow];
#pragma unroll
        for (int d0 = 0; d0 < 4; ++d0) {
            const float v = o[d0][r] * rl;
            const float vn = __shfl_xor(v, 1);
            if ((r32 & 1) == 0) *(unsigned*)(obuf + (size_t)orow * 1024 + d0 * 32 + r32) = cvt_pk_bf16(v, vn);
        }
    }
    __syncthreads();
    float* impS = (float*)K_lds;
    unsigned* selw = (unsigned*)(lds + A_OFF_SEL);
    {
        const int cur = qb;
#pragma unroll
        for (int i = 0; i < 4; ++i) {
            const int j = wid * 4 + i;
            float s = 0.f;
#pragma unroll
            for (int hh = 0; hh < 4; ++hh) s += slab[(hh * 32 + j) * 64 + lane];
            const bool forced = (j == 0) || (j == cur) || (j == cur - 1);
            impS[j * 64 + lane] = forced ? 1e6f : (j <= cur ? s : -1e6f);
        }
        if (wid == 0) selw[lane] = 0u;
    }
    __syncthreads();
    {
        float imp[32];
#pragma unroll
        for (int j = 0; j < 32; ++j) imp[j] = impS[j * 64 + lane];
        unsigned mask = 0;
#pragma unroll
        for (int i = 0; i < 4; ++i) {
            const int j = wid * 4 + i;
            const float mine = impS[j * 64 + lane];
            int rank = 0;
#pragma unroll
            for (int j2 = 0; j2 < 32; ++j2) rank += (imp[j2] > mine || (imp[j2] == mine && j2 < j)) ? 1 : 0;
            mask |= rank < 16 ? (1u << j) : 0u;
        }
        atomicOr(&selw[lane], mask);
    }
}

constexpr int CMP_KS = 8;
__device__ __forceinline__ void cmp1_unit(const P& p, char* shm, int u) {
    {
        const int ks = u % CMP_KS, mt = (u / CMP_KS) & 3, kv = u / (4 * CMP_KS);
        const bf16_t* A = p.projb + (kv ? OFF_VC : OFF_KC);
        float* C = p.hidp + ((size_t)(kv * CMP_KS + ks) * 1024 + mt * 256) * CMPH;
        gemm256<false>(A,
                [=](int r) { int m = mt * 256 + r; m = m < CMPR ? m : CMPR - 1; const int g = m & 1, bn = m >> 1, n = bn % NCMP, b = bn / NCMP; return (b * S + 16 * n) * IN_PAD + g * DH; },
                [=](int kt) { const int ka = ks * (4096 / CMP_KS / G_BK) + kt; return (ka >> 1) * IN_PAD + (ka & 1) * G_BK; },
                p.w1T + (size_t)kv * CMPH * 4096 + ks * (4096 / CMP_KS), 4096, 4096 / CMP_KS, shm,
                [=](const f32x4 (&acc)[2][2][4][2], int wr, int wc, int fr, int fq) {
#pragma unroll
                    for (int ai = 0; ai < 2; ++ai)
#pragma unroll
                        for (int m = 0; m < 4; ++m)
#pragma unroll
                            for (int bj = 0; bj < 2; ++bj)
#pragma unroll
                                for (int n = 0; n < 2; ++n)
                                    *(f32x4*)(C + (size_t)(ai * 128 + wr * 64 + m * 16 + fr) * CMPH + bj * 128 + wc * 32 + n * 16 + fq * 4) = acc[ai][bj][m][n];
                });
    }
}
__device__ __forceinline__ void ph_cmp_bias(const P& p, float* lds) {
    const int tid = threadIdx.x, tx = tid & 15, ty = tid >> 4;
    for (int u = blockIdx.x; u < 8; u += gridDim.x) {
        const int kv = u >> 2, n0 = (u & 3) * 64 + tx * 4;
        const float* pos = kv ? p.cmp_pos_v : p.cmp_pos_k; const float* w1 = kv ? p.cmp_v_w1 : p.cmp_k_w1;
        float a0 = 0.f, a1 = 0.f, a2 = 0.f, a3 = 0.f;
#pragma unroll 4
        for (int k = ty * 128; k < ty * 128 + 128; ++k) {
            const float4 w = *(const float4*)(w1 + (size_t)k * CMPH + n0); const float pv = pos[k];
            a0 += pv * w.x; a1 += pv * w.y; a2 += pv * w.z; a3 += pv * w.w;
        }
        __syncthreads();
        lds[ty * 64 + tx * 4 + 0] = a0; lds[ty * 64 + tx * 4 + 1] = a1; lds[ty * 64 + tx * 4 + 2] = a2; lds[ty * 64 + tx * 4 + 3] = a3;
        __syncthreads();
        if (tid < 64) { float s = 0.f; for (int i = 0; i < 32; ++i) s += lds[i * 64 + tid]; p.bias1[kv * CMPH + (u & 3) * 64 + tid] = s; }
        __syncthreads();
    }
}
__device__ __forceinline__ void cmp2_block_unit(const P& p, float* lds, int j) {
    int tid = threadIdx.x; asm volatile("" : "+v"(tid));
    const int w = tid >> 6, lane = tid & 63;
    float* hs = lds + w * 1024;
    const int kv = j >> 5, r0 = (j & 31) * 32 + w * 4;
    if (r0 < CMPR) {
        const f32x4 b1 = *(const f32x4*)(p.bias1 + kv * CMPH + lane * 4);
#pragma unroll 2
        for (int q = 0; q < 4; ++q) {
            f32x4 s = b1;
#pragma unroll
            for (int ks = 0; ks < CMP_KS; ++ks) s += *(const f32x4*)(p.hidp + ((size_t)(kv * CMP_KS + ks) * 1024 + r0 + q) * CMPH + lane * 4);
            f32x4 g; for (int j = 0; j < 4; ++j) g[j] = gelu_tanh(s[j]);
            *(f32x4*)(hs + q * 256 + lane * 4) = g;
        }
        const float* w2 = kv ? p.cmp_v_w2 : p.cmp_k_w2;
        float o[4][2] = {};
        for (int k0 = 0; k0 < CMPH; k0 += 32) {
            float2 wv[32];
#pragma unroll
            for (int i = 0; i < 32; ++i) wv[i] = *(const float2*)(w2 + (size_t)(k0 + i) * DH + 2 * lane);
#pragma unroll
            for (int i8 = 0; i8 < 32; i8 += 8) {
#pragma unroll
                for (int i = i8; i < i8 + 8; ++i)
#pragma unroll
                    for (int q = 0; q < 4; ++q) { const float hv = hs[q * 256 + k0 + i]; o[q][0] += hv * wv[i].x; o[q][1] += hv * wv[i].y; }
                __builtin_amdgcn_sched_barrier(0);
            }
        }
#pragma unroll
        for (int q = 0; q < 4; ++q) {
            float v0 = o[q][0], v1 = o[q][1];
            if (kv == 0) { const float rs = rsqrtf(wave_sum(v0 * v0 + v1 * v1) / DH + EPS); v0 *= rs * p.nsa_k_norm[2 * lane]; v1 *= rs * p.nsa_k_norm[2 * lane + 1]; }
            *(unsigned*)(p.cmpb + ((size_t)kv * 1024 + r0 + q) * DH + 2 * lane) = pk_bf16(v0, v1);
        }
    }
}

__device__ __forceinline__ void sync_publish(unsigned* ctr) {
    asm volatile("s_waitcnt vmcnt(0)" ::: "memory");
    __syncthreads();
    if (threadIdx.x == 0) {
        __builtin_amdgcn_fence(__ATOMIC_RELEASE, "agent");
        asm volatile("s_waitcnt vmcnt(0)" ::: "memory");
        (void)__hip_atomic_fetch_add(ctr, 1u, __ATOMIC_RELAXED, __HIP_MEMORY_SCOPE_AGENT);
    }
}
__device__ __forceinline__ void sync_wait_ge(unsigned* ctr, unsigned target) {
    if (threadIdx.x == 0) {
        unsigned sp = 0;
        while (__hip_atomic_load(ctr, __ATOMIC_RELAXED, __HIP_MEMORY_SCOPE_AGENT) < target) { __builtin_amdgcn_s_sleep(1); if (++sp > (1u << 22)) break; }
        __builtin_amdgcn_fence(__ATOMIC_ACQUIRE, "agent");
        asm volatile("s_waitcnt vmcnt(0)" ::: "memory");
    }
    __syncthreads();
}
constexpr int SY_CMP1 = 0, SY_CMP2 = 8;
__device__ __forceinline__ void ph_attention(const P& p, char* lds, int qo = 0) {
    unsigned* sy = p.sync;
    if (blockIdx.x < 2 * 4 * CMP_KS) {
        const int u = blockIdx.x;
        cmp1_unit(p, lds, u);
        sync_publish(sy + (SY_CMP1 + (u / CMP_KS)) * 64);
        const int kv2 = u >> 5, mt2 = (u & 31) >> 3;
        sync_wait_ge(sy + (SY_CMP1 + kv2 * 4 + mt2) * 64, CMP_KS);
        cmp2_block_unit(p, (float*)lds, u);
        sync_publish(sy + SY_CMP2 * 64);
        __syncthreads();
    }
    for (;;) {
        const int u = next_unit(p.queue + 0 + qo, lds);
        if (u >= 256) break;
        const int bh = u & 31;
        attn_unit<2>(p, bh >> 3, bh & 7, 7 - (u >> 5), lds);
    }
    a_build_tbl(p, lds);
    sync_wait_ge(sy + SY_CMP2 * 64, 2 * 4 * CMP_KS);
    for (;;) {
        const int u = next_unit(p.queue + 16 + qo, lds);
        if (u >= 256) break;
        const int bg = u & 7, qb = 31 - (u >> 3);
        cmpattn_unit(p, bg >> 1, bg & 1, qb, lds);
        attn_unit<1>(p, bg >> 1, bg & 1, qb, lds);
    }
    for (;;) {
        const int u = next_unit(p.queue + 32 + qo, lds);
        if (u >= 256) break;
        const int bg = u & 7;
        attn_unit<0>(p, bg >> 1, bg & 1, 31 - (u >> 3), lds);
    }
}

constexpr int LDS_BAR_OFF = 139776;
constexpr int LDS_TOTAL = LDS_BAR_OFF + 64;
__global__ void __launch_bounds__(NTHR, 2) k_mega(P p) {
    extern __shared__ __attribute__((aligned(16))) char shm[];
    float* lds = (float*)shm;
    volatile LAS unsigned* xbw = (volatile LAS unsigned*)(shm + LDS_BAR_OFF);
    if (threadIdx.x == 0) { xbw[0] = 0u; xbw[1] = 0u; xbw[2] = 0u; xbw[3] = 0u; }
    __syncthreads();
    XcdBarrier bar = xcd_barrier_post(p.bar, xbw);
    ph_mod(p, lds); __syncthreads(); ph_cmp_bias(p, lds); __syncthreads(); ph_convert(p, shm);   xcd_barrier(bar);
    ph_rms1_b(p, lds);                               xcd_barrier(bar);
    ph_inproj_fast(p, shm);                          xcd_barrier(bar);
    ph_attention(p, shm);                            xcd_barrier(bar);
    ph_combine(p, lds);                              xcd_barrier(bar);
    ph_outproj_fast(p, shm);                         xcd_barrier(bar);
    ph_router_fast(p, shm);                          xcd_barrier(bar);
    ph_up_fast(p, shm);                              xcd_barrier(bar);
    ph_down_fast(p, shm);                            xcd_barrier(bar);
    ph_final_fast(p);
}
}

extern "C" void kernel_launch(void* const* d_in, const int* in_sizes, int n_in, void* d_out, int out_size, void* d_ws, size_t ws_size,
                              hipStream_t stream) {
    (void)in_sizes; (void)n_in; (void)out_size;
    P p{};
    const float* const* in = (const float* const*)d_in;
    p.x = in[0]; p.c = in[1]; p.rel_bias = in[2]; p.mod_w = in[3]; p.mod_b = in[4]; p.norm_attn = in[5]; p.norm_moe = in[6]; p.w_in = in[7];
    p.b_nsa_gate = in[8]; p.nsa_q_norm = in[9]; p.nsa_k_norm = in[10]; p.cmp_pos_k = in[11]; p.cmp_pos_v = in[12]; p.cmp_k_w1 = in[13];
    p.cmp_k_w2 = in[14]; p.cmp_v_w1 = in[15]; p.cmp_v_w2 = in[16]; p.fox_q_norm = in[17]; p.fox_k_norm = in[18]; p.fox_forget_bias = in[19];
    p.out_norm = in[20]; p.w_out = in[21]; p.router_w = in[22]; p.router_b = in[23]; p.w_up = in[24]; p.b_up = in[25]; p.w_down = in[26];
    p.b_down = in[27];
    p.out = (float*)d_out;
    char* ws = (char*)d_ws; size_t off = 0;
    auto take = [&](size_t bytes) { void* r = ws + off; off += (bytes + 255) & ~(size_t)255; return r; };
    p.bar = (unsigned*)take(XCD_BAR_WORDS * sizeof(unsigned));
    p.queue = (int*)take(64 * sizeof(int));
    p.cnt = (int*)take(NE * 64 * sizeof(int));
    p.sync = (unsigned*)take(16 * 64 * sizeof(unsigned));
    const size_t zero_bytes = off;
    p.mod = (float*)take((size_t)NB * 6 * D * 4);
    p.cum = (float*)take((size_t)NB * 8 * S * 4);
    p.x1 = (bf16_t*)take((size_t)T * D * 2);
    p.row_w = (float*)take((size_t)NE * CAP * 4);
    p.row_a = (int*)take((size_t)NE * CAP * 4);
    p.gatesf = (float*)take((size_t)T * 24 * 4);
    p.logf = (float*)take((size_t)T * 8 * 4);
    p.hidp = (float*)take((size_t)2 * CMP_KS * 1024 * CMPH * 4);
    p.bias1 = (float*)take((size_t)2 * CMPH * 4);
    p.winT = (bf16_t*)take((size_t)IN_PAD * D * 2);
    p.woutT = (bf16_t*)take((size_t)D * D * 2);
    p.w1T = (bf16_t*)take((size_t)2 * CMPH * 4096 * 2);
    p.w2T = (bf16_t*)take((size_t)2 * 256 * CMPH * 2);
    p.hb = (bf16_t*)take((size_t)T * D * 2);
    p.projb = (bf16_t*)take((size_t)T * IN_PAD * 2);
    p.mixb = (bf16_t*)take((size_t)T * D * 2);
    p.owinb = (bf16_t*)take((size_t)T * 1024 * 2);
    p.oslcb = (bf16_t*)take((size_t)T * 1024 * 2);
    p.ofoxb = (bf16_t*)take((size_t)T * 1024 * 2);
    p.ocmpb = (bf16_t*)take((size_t)T * 1024 * 2);
    p.cmpb = (bf16_t*)take((size_t)2 * 1024 * DH * 2);
    p.yq = (unsigned char*)take((size_t)TK * D);
    p.wupq = (unsigned char*)take((size_t)NE * 2 * F * D);
    p.wdnq = (unsigned char*)take((size_t)NE * D * F);
    p.xgq = (unsigned char*)take((size_t)NE * CAP * D);
    p.actq = (unsigned char*)take((size_t)NE * CAP * F);
    p.winq = (unsigned char*)take((size_t)IN_PAD * D);
    p.hq = (unsigned char*)take((size_t)T * D);
    if (off > ws_size) { fprintf(stderr, "kernel_launch: workspace too small (%zu > %zu)\n", off, ws_size); return; }

    constexpr size_t kDynLds = LDS_TOTAL;
    constexpr int kBlocksPerCu = 1;
    static int grid = 0;
    if (!grid) {
        int dev = 0, cus = 0, per_cu = 0;
        (void)hipGetDevice(&dev);
        (void)hipDeviceGetAttribute(&cus, hipDeviceAttributeMultiprocessorCount, dev);
        (void)hipFuncSetAttribute((const void*)k_mega, hipFuncAttributeMaxDynamicSharedMemorySize, (int)kDynLds);
        (void)hipOccupancyMaxActiveBlocksPerMultiprocessor(&per_cu, k_mega, NTHR, kDynLds);
        if (cus <= 0) cus = 256;
        if (per_cu < 1) per_cu = 1;
        grid = cus * (per_cu < kBlocksPerCu ? per_cu : kBlocksPerCu);
    }
    (void)hipMemsetAsync(ws, 0, zero_bytes, stream);
    k_mega<<<grid, NTHR, kDynLds, stream>>>(p);
}
```

```cpp
#include <hip/hip_runtime.h>
#include <stdint.h>
#include <stdio.h>

#define XB_TMO      128
#define XB_XCNT(j)  (256  + 64 * (j))
#define XB_XSUB(j)  (1280 + 64 * (j))
#define XB_XGEN(j)  (2304 + 64 * (j))
#define XB_TOP      3328
#define XB_TOPGEN   3392
#define XCD_BAR_WORDS 3456
#define XB_SPIN_CAP (1u << 18)
#define LAS __attribute__((address_space(3)))

__device__ __forceinline__ unsigned xb_ld(unsigned* p)              { return __hip_atomic_load(p, __ATOMIC_RELAXED, __HIP_MEMORY_SCOPE_AGENT); }
__device__ __forceinline__ unsigned xb_add(unsigned* p, unsigned v) { return __hip_atomic_fetch_add(p, v, __ATOMIC_RELAXED, __HIP_MEMORY_SCOPE_AGENT); }
__device__ __forceinline__ unsigned xb_xcc_id() { return (unsigned)__builtin_amdgcn_s_getreg((3 << 11) | 20) & 0xFu; }
#define XB_SPIN(cond, bar) do { unsigned _sp = 0; while (cond) { __builtin_amdgcn_s_sleep(1); \
    if ((++_sp & 255u) == 0u) { if (xb_ld(&(bar)[XB_TMO])) break; if (_sp > XB_SPIN_CAP) { atomicAdd(&(bar)[XB_TMO], 1u); break; } } } } while (0)

struct XcdBarrier {
    unsigned* bar; unsigned x;
    volatile LAS unsigned* st;
};

__device__ __forceinline__ XcdBarrier xcd_barrier_post(unsigned* bar, volatile LAS unsigned* st) {
    XcdBarrier b; b.bar = bar; b.x = xb_xcc_id(); b.st = st;
    if (threadIdx.x == 0) (void)xb_add(&bar[XB_XCNT(b.x)], 1u);
    return b;
}
__device__ __forceinline__ void xcd_barrier_complete(unsigned* bar, unsigned x, unsigned& nloc, unsigned& nx) {
    const unsigned G = gridDim.x * gridDim.y * gridDim.z;
    unsigned sum, cnt, mine, sp = 0u;
    for (;;) {
        sum = 0u; cnt = 0u; mine = 0u;
#pragma unroll
        for (unsigned j = 0; j < 16; ++j) { const unsigned c = xb_ld(&bar[XB_XCNT(j)]); sum += c; cnt += (c > 0u) ? 1u : 0u; mine = (j == x) ? c : mine; }
        if (sum == G) break;
        __builtin_amdgcn_s_sleep(1);
        if ((++sp & 255u) == 0u) { if (xb_ld(&bar[XB_TMO])) break; if (sp > XB_SPIN_CAP) { atomicAdd(&bar[XB_TMO], 1u); break; } }
    }
    nloc = mine > 0u ? mine : 1u; nx = cnt > 0u ? cnt : 1u;
}

__device__ __forceinline__ void xcd_barrier(const XcdBarrier& b) {
    asm volatile("s_waitcnt vmcnt(0)" ::: "memory");
    __syncthreads();
    if (threadIdx.x == 0) {
        unsigned* bar = b.bar;
        __builtin_amdgcn_s_waitcnt(0);
        unsigned nloc = b.st[0], nx = b.st[1];
        if (nloc == 0u) { xcd_barrier_complete(bar, b.x, nloc, nx); b.st[0] = nloc; b.st[1] = nx; }
        const unsigned old = xb_add(&bar[XB_XSUB(b.x)], 1u);
        const unsigned gen = old / nloc;
        if (old + 1u == (gen + 1u) * nloc) {
            __builtin_amdgcn_fence(__ATOMIC_RELEASE, "agent");
            asm volatile("s_waitcnt vmcnt(0)" ::: "memory");
            const unsigned og = xb_add(&bar[XB_TOP], 1u);
            const unsigned tg = og / nx;
            if (og + 1u == (tg + 1u) * nx) xb_add(&bar[XB_TOPGEN], 1u);
            else XB_SPIN(xb_ld(&bar[XB_TOPGEN]) == tg, bar);
            __builtin_amdgcn_fence(__ATOMIC_ACQUIRE, "agent");
            xb_add(&bar[XB_XGEN(b.x)], 1u);
            asm volatile("s_waitcnt vmcnt(0)" ::: "memory");
        } else {
            XB_SPIN(xb_ld(&bar[XB_XGEN(b.x)]) == gen, bar);
            __builtin_amdgcn_fence(__ATOMIC_ACQUIRE, "agent");
            asm volatile("s_waitcnt vmcnt(0)" ::: "memory");
        }
    }
    __syncthreads();
}


namespace {
typedef unsigned short bf16_t;
typedef float f32x4 __attribute__((ext_vector_type(4)));
constexpr int D = 2048, NB = 4, S = 2048, T = NB * S;
constexpr int DH = 128, G = 2, R = 4;
constexpr int D_IN = 5664;
constexpr int OFF_QN = 0, OFF_KC = 1024, OFF_VC = 1280, OFF_KS = 1536, OFF_VS = 1792, OFF_KW = 2048, OFF_VW = 2304,
              OFF_QF = 2560, OFF_KF = 3584, OFF_VF = 4608, OFF_GN = 5632, OFF_FF = 5656;
__host__ __device__ constexpr int in_colmap(int n) { return n < 2560 ? n : n < 2584 ? 5632 + (n - 2560) : n < 5656 ? n - 24 : n; }
constexpr int NCMP = 127, CMPH = 256, CMPR = NB * NCMP * G;
constexpr int NE = 32, F = 2048, TK = T * 4;
constexpr float SCALE = 0.08838834764831845f;
constexpr float EPS = 1e-6f;
constexpr int NTHR = 512;

__device__ const unsigned char BUCKET[128] = {
 0, 1, 2, 3, 4, 5, 6, 7, 8, 9, 10, 11, 12, 13, 14, 15, 16, 16, 16, 17, 17, 18, 18, 18, 19, 19, 19, 20, 20, 20, 20, 21,
 21, 21, 21, 22, 22, 22, 22, 22, 23, 23, 23, 23, 23, 23, 24, 24, 24, 24, 24, 24, 25, 25, 25, 25, 25, 25, 25, 26, 26, 26, 26, 26,
 26, 26, 26, 27, 27, 27, 27, 27, 27, 27, 27, 27, 27, 28, 28, 28, 28, 28, 28, 28, 28, 28, 28, 29, 29, 29, 29, 29, 29, 29, 29, 29,
 29, 29, 29, 30, 30, 30, 30, 30, 30, 30, 30, 30, 30, 30, 30, 30, 30, 31, 31, 31, 31, 31, 31, 31, 31, 31, 31, 31, 31, 31, 31, 31};
__device__ __forceinline__ int t5bucket(int d) { return BUCKET[d > 127 ? 127 : d]; }

struct P {
    const float *x, *c, *rel_bias, *mod_w, *mod_b, *norm_attn, *norm_moe, *w_in, *b_nsa_gate, *nsa_q_norm, *nsa_k_norm,
        *cmp_pos_k, *cmp_pos_v, *cmp_k_w1, *cmp_k_w2, *cmp_v_w1, *cmp_v_w2, *fox_q_norm, *fox_k_norm, *fox_forget_bias,
        *out_norm, *w_out, *router_w, *router_b, *w_up, *b_up, *w_down, *b_down;
    float* out;
    float *mod, *cum, *row_w, *gatesf, *logf, *hidp, *bias1;
    int *cnt, *queue, *row_a; unsigned* bar; unsigned* sync;
    bf16_t *x1, *winT, *woutT, *w1T, *w2T, *hb, *projb, *mixb, *owinb, *oslcb, *ofoxb, *ocmpb, *cmpb;
    unsigned char *wupq, *wdnq, *xgq, *actq, *winq, *hq, *yq;
};

__device__ __forceinline__ float wave_sum(float v) {
#pragma unroll
    for (int o = 32; o > 0; o >>= 1) v += __shfl_xor(v, o);
    return v;
}
__device__ __forceinline__ float wave_max(float v) {
#pragma unroll
    for (int o = 32; o > 0; o >>= 1) v = fmaxf(v, __shfl_xor(v, o));
    return v;
}
__device__ __forceinline__ float bf2f(bf16_t v) { return __uint_as_float(((unsigned)v) << 16); }
__device__ __forceinline__ float bflo(unsigned w) { return __uint_as_float(w << 16); }
__device__ __forceinline__ float bfhi(unsigned w) { return __uint_as_float(w & 0xffff0000u); }
__device__ __forceinline__ unsigned pk_bf16(float lo, float hi) { unsigned r; asm("v_cvt_pk_bf16_f32 %0, %1, %2" : "=v"(r) : "v"(lo), "v"(hi)); return r; }
constexpr int IN_PAD = 5888;
__device__ __forceinline__ float block_sum(float v, float* red) {
    v = wave_sum(v);
    const int w = threadIdx.x >> 6;
    __syncthreads();
    if ((threadIdx.x & 63) == 0) red[w] = v;
    __syncthreads();
    float s = 0.f;
    for (int i = 0; i < (int)(blockDim.x >> 6); ++i) s += red[i];
    return s;
}

__device__ __forceinline__ void ph_mod(const P& p, float* lds) {
    const int tid = threadIdx.x, tx = tid & 15, ty = tid >> 4;
    float* sc = lds + 8192;
    if (blockIdx.x < 6 * D / 64) {
        for (int i = tid; i < 4 * D; i += NTHR) { const float cv = p.c[i]; sc[i] = cv / (1.f + __expf(-cv)); }
    }
    __syncthreads();
    for (int u = blockIdx.x; u < 6 * D / 64; u += gridDim.x) {
        const int n0 = u * 64 + tx * 4;
        float acc[4][4] = {};
        for (int k0 = ty * 64; k0 < ty * 64 + 64; k0 += 8) {
            float4 w[8];
#pragma unroll
            for (int i = 0; i < 8; ++i) w[i] = *(const float4*)(p.mod_w + (size_t)(k0 + i) * (6 * D) + n0);
#pragma unroll
            for (int i = 0; i < 8; ++i)
#pragma unroll
                for (int b = 0; b < 4; ++b) {
                    const float sv = sc[b * D + k0 + i];
                    acc[b][0] += sv * w[i].x; acc[b][1] += sv * w[i].y; acc[b][2] += sv * w[i].z; acc[b][3] += sv * w[i].w;
                }
        }
        __syncthreads();
#pragma unroll
        for (int b = 0; b < 4; ++b)
#pragma unroll
            for (int j = 0; j < 4; ++j) lds[(ty * 4 + b) * 64 + tx * 4 + j] = acc[b][j];
        __syncthreads();
        if (tid < 256) {
            const int b = tid >> 6, n = tid & 63;
            float s = 0.f;
            for (int i = 0; i < 32; ++i) s += lds[(i * 4 + b) * 64 + n];
            p.mod[b * 6 * D + u * 64 + n] = s + p.mod_b[u * 64 + n];
        }
    }
}

__device__ __forceinline__ void ph_rms1_b(const P& p, float* lds) {
    const int tid = threadIdx.x, w = tid >> 6, lane = tid & 63;
    for (int t = blockIdx.x * 8 + w; t < T; t += gridDim.x * 8) {
        const int b = t / S;
        f32x4 v[8]; float ss = 0.f;
#pragma unroll
        for (int i = 0; i < 8; ++i) { v[i] = *(const f32x4*)(p.x + (size_t)t * D + (i * 64 + lane) * 4); ss += v[i][0] * v[i][0] + v[i][1] * v[i][1] + v[i][2] * v[i][2] + v[i][3] * v[i][3]; }
        const float rs = rsqrtf(wave_sum(ss) / D + EPS);
        const float* scp = p.mod + (size_t)b * 6 * D + 1 * D; const float* shp = p.mod + (size_t)b * 6 * D;
#pragma unroll
        for (int i = 0; i < 8; ++i) {
            const int c = (i * 64 + lane) * 4;
            const f32x4 g = *(const f32x4*)(p.norm_attn + c), sc = *(const f32x4*)(scp + c), sh = *(const f32x4*)(shp + c);
            f32x4 o; for (int j = 0; j < 4; ++j) o[j] = v[i][j] * rs * g[j] * (1.f + sc[j]) + sh[j];
            int ow = 0; ow = __builtin_amdgcn_cvt_pk_fp8_f32(o[0], o[1], ow, false); ow = __builtin_amdgcn_cvt_pk_fp8_f32(o[2], o[3], ow, true);
            *(int*)(p.hq + (size_t)t * D + c) = ow;
            uint2 ob; ob.x = pk_bf16(o[0], o[1]); ob.y = pk_bf16(o[2], o[3]);
            *(uint2*)(p.hb + (size_t)t * D + c) = ob;
        }
    }
}

__device__ __forceinline__ float log_sigmoid(float x) { return fminf(x, 0.f) - log1pf(__expf(-fabsf(x))); }
__device__ __forceinline__ void ph_postproj(const P& p) {
    const int tid = threadIdx.x, w = tid >> 6, lane = tid & 63;
    for (int t = blockIdx.x * 8 + w; t < T; t += gridDim.x * 8) {
        bf16_t* row = p.projb + (size_t)t * IN_PAD;
        unsigned wv[28];
#pragma unroll
        for (int hh = 0; hh < 28; ++hh) {
            const int off = hh < 8 ? OFF_QN + hh * DH : hh < 10 ? OFF_KS + (hh - 8) * DH : hh < 12 ? OFF_KW + (hh - 10) * DH : hh < 20 ? OFF_QF + (hh - 12) * DH : OFF_KF + (hh - 20) * DH;
            wv[hh] = *(const unsigned*)(row + off + 2 * lane);
        }
        const float gate_in = lane < 24 ? bf2f(row[OFF_GN + lane]) : 0.f;
        const float f_in = lane < 8 ? bf2f(row[OFF_FF + lane]) : 0.f;
#pragma unroll
        for (int hh = 0; hh < 28; ++hh) {
            const int off = hh < 8 ? OFF_QN + hh * DH : hh < 10 ? OFF_KS + (hh - 8) * DH : hh < 12 ? OFF_KW + (hh - 10) * DH : hh < 20 ? OFF_QF + (hh - 12) * DH : OFF_KF + (hh - 20) * DH;
            const float* gw = hh < 8 ? p.nsa_q_norm : hh < 10 ? p.nsa_k_norm + DH : hh < 12 ? p.nsa_k_norm + 2 * DH : hh < 20 ? p.fox_q_norm : p.fox_k_norm;
            const float a = bflo(wv[hh]), b = bfhi(wv[hh]);
            const float rs = rsqrtf(wave_sum(a * a + b * b) / DH + EPS);
            const float2 g2 = *(const float2*)(gw + 2 * lane);
            *(unsigned*)(row + off + 2 * lane) = pk_bf16(a * rs * g2.x, b * rs * g2.y);
        }
        if (lane < 24) p.gatesf[(size_t)t * 24 + lane] = 1.f / (1.f + __expf(-(gate_in + p.b_nsa_gate[lane])));
        if (lane < 8) p.logf[(size_t)t * 8 + lane] = log_sigmoid(f_in + p.fox_forget_bias[lane]);
    }
}

__device__ __forceinline__ void ph_cumsum(const P& p, float* lds) {
    const int tid = threadIdx.x;
    for (int u = blockIdx.x; u < NB * 8; u += gridDim.x) {
        const int b = u >> 3, hh = u & 7;
        float v[4]; float s = 0.f;
#pragma unroll
        for (int i = 0; i < 4; ++i) { v[i] = p.logf[(size_t)(b * S + tid * 4 + i) * 8 + hh]; s += v[i]; v[i] = s; }
        __syncthreads();
        lds[tid] = s;
        __syncthreads();
        if (tid < 64) {
            float q[8], r = 0.f;
#pragma unroll
            for (int i = 0; i < 8; ++i) { q[i] = lds[tid * 8 + i]; r += q[i]; }
            float inc = r;
#pragma unroll
            for (int o = 1; o < 64; o <<= 1) { const float n = __shfl_up(inc, o); if (tid >= o) inc += n; }
            float run = inc - r;
#pragma unroll
            for (int i = 0; i < 8; ++i) { lds[tid * 8 + i] = run; run += q[i]; }
        }
        __syncthreads();
        const float base = lds[tid];
#pragma unroll
        for (int i = 0; i < 4; ++i) p.cum[(size_t)u * S + tid * 4 + i] = base + v[i];
        __syncthreads();
    }
}

__device__ __forceinline__ float gelu_tanh(float x) {
    const float u = 0.7978845608028654f * (x + 0.044715f * x * x * x);
    return 0.5f * x * (1.f + tanhf(u));
}
__device__ __forceinline__ void ph_combine(const P& p, float* lds) {
    const int tid = threadIdx.x, w = tid >> 6, lane = tid & 63;
    for (int t = blockIdx.x * 8 + w; t < T; t += gridDim.x * 8) {
        const float* gates = p.gatesf + (size_t)t * 24;
        float a[8][2], f[8][2]; float sa = 0.f, sf = 0.f;
#pragma unroll
        for (int i = 0; i < 8; ++i) {
            const size_t o = (size_t)t * 1024 + 2 * (i * 64 + lane);
            const float g0 = gates[i], g1 = gates[8 + i], g2 = gates[16 + i];
            const unsigned sw = *(const unsigned*)(p.oslcb + o), ww = *(const unsigned*)(p.owinb + o), fw = *(const unsigned*)(p.ofoxb + o);
            float c0, c1;
            { const unsigned cw = *(const unsigned*)(p.ocmpb + o); c0 = bflo(cw); c1 = bfhi(cw); }
            a[i][0] = g0 * c0 + g1 * bflo(sw) + g2 * bflo(ww); a[i][1] = g0 * c1 + g1 * bfhi(sw) + g2 * bfhi(ww);
            f[i][0] = bflo(fw); f[i][1] = bfhi(fw);
            sa += a[i][0] * a[i][0] + a[i][1] * a[i][1]; sf += f[i][0] * f[i][0] + f[i][1] * f[i][1];
        }
        const float ra = rsqrtf(wave_sum(sa) / 1024.f + EPS), rf = rsqrtf(wave_sum(sf) / 1024.f + EPS);
        bf16_t* mo = p.mixb + (size_t)t * D;
#pragma unroll
        for (int i = 0; i < 8; ++i) {
            const int c = 2 * (i * 64 + lane);
            const float2 n0 = *(const float2*)(p.out_norm + c), n1 = *(const float2*)(p.out_norm + 1024 + c);
            *(unsigned*)(mo + c) = pk_bf16(a[i][0] * ra * n0.x, a[i][1] * ra * n0.y);
            *(unsigned*)(mo + 1024 + c) = pk_bf16(f[i][0] * rf * n1.x, f[i][1] * rf * n1.y);
        }
    }
}

typedef short bf16x8 __attribute__((ext_vector_type(8)));
typedef float f32x16 __attribute__((ext_vector_type(16)));
typedef unsigned u32x4 __attribute__((ext_vector_type(4)));
typedef unsigned u32x2 __attribute__((ext_vector_type(2)));
typedef float f32x2 __attribute__((ext_vector_type(2)));

__device__ __forceinline__ unsigned cvt_pk_bf16(float lo, float hi) { unsigned r; asm("v_cvt_pk_bf16_f32 %0, %1, %2" : "=v"(r) : "v"(lo), "v"(hi)); return r; }
__device__ __forceinline__ float bf16_lo(unsigned w) { return __uint_as_float(w << 16); }
__device__ __forceinline__ float bf16_hi(unsigned w) { return __uint_as_float(w & 0xffff0000u); }
__device__ __forceinline__ float bf16_f(bf16_t v) { return __uint_as_float(((unsigned)v) << 16); }
__device__ __forceinline__ f32x4 bf16x4_f(u32x2 w) { return (f32x4){bf16_lo(w.x), bf16_hi(w.x), bf16_lo(w.y), bf16_hi(w.y)}; }

typedef int i32x8 __attribute__((ext_vector_type(8)));
typedef int i32x4 __attribute__((ext_vector_type(4)));
constexpr int F8_SCALE_W = 0x79797979, F8_SCALE_A = 0x7F7F7F7F;
constexpr float F8_WMUL = 64.f;
__device__ __forceinline__ int perm32(int rho) { const int n = rho >> 4, i = rho & 15; return 8 * (i >> 2) + 4 * n + (i & 3); }
constexpr unsigned long long CVT_IN_BF_TILES = 0x1FF0001CCC00ull, CVT_IN_F8_TILES = 0x1FFFF333FFull;
constexpr int CVT_N_IN_BF = 16, CVT_N_IN_F8 = 31;
__device__ __forceinline__ int nth_set_bit(unsigned long long m, int j) { int b = 0; for (;; ++b) if ((m >> b) & 1) { if (j-- == 0) break; } return b; }
constexpr int CVT_T_IN = 16 * CVT_N_IN_BF, CVT_T_INQ = 8 * CVT_N_IN_F8, CVT_T_OUT = 16 * 16, CVT_T_W1 = 32 * 2, CVT_T_W2 = 2 * 2, CVT_T_UP = 8 * 32, CVT_T_DN = 8 * 16;
constexpr int CVT_B_OUT = CVT_T_IN, CVT_B_W1K = CVT_B_OUT + CVT_T_OUT, CVT_B_W1V = CVT_B_W1K + CVT_T_W1, CVT_B_W2K = CVT_B_W1V + CVT_T_W1,
              CVT_B_W2V = CVT_B_W2K + CVT_T_W2, CVT_B_UP = CVT_B_W2V + CVT_T_W2, CVT_B_DN = CVT_B_UP + NE * CVT_T_UP, CVT_B_INQ = CVT_B_DN + NE * CVT_T_DN, CVT_TOTAL = CVT_B_INQ + CVT_T_INQ;

struct CvtTile { const float* src; bf16_t* dst; int ldn, K, nvalid, k0, n0, drow0, perm; };
__device__ __forceinline__ CvtTile cvt_decode(const P& p, int u) {
    CvtTile t; int local, nNt; int mode = 0; t.perm = (u >= CVT_B_INQ || u < CVT_B_OUT) ? 1 : 0;
    if (u < CVT_B_OUT) { local = u; nNt = CVT_N_IN_BF; t.src = p.w_in; t.dst = p.winT; t.ldn = D_IN; t.K = D; t.nvalid = D_IN; }
    else if (u >= CVT_B_INQ) { local = u - CVT_B_INQ; nNt = CVT_N_IN_F8; t.src = p.w_in; t.dst = (bf16_t*)p.winq; t.ldn = D_IN; t.K = D; t.nvalid = D_IN; }
    else if (u < CVT_B_W1K) { local = u - CVT_B_OUT; nNt = 16; t.src = p.w_out; t.dst = p.woutT; t.ldn = D; t.K = D; t.nvalid = D; }
    else if (u < CVT_B_W1V) { local = u - CVT_B_W1K; nNt = 2; t.src = p.cmp_k_w1; t.dst = p.w1T; t.ldn = CMPH; t.K = 4096; t.nvalid = CMPH; }
    else if (u < CVT_B_W2K) { local = u - CVT_B_W1V; nNt = 2; t.src = p.cmp_v_w1; t.dst = p.w1T + (size_t)CMPH * 4096; t.ldn = CMPH; t.K = 4096; t.nvalid = CMPH; }
    else if (u < CVT_B_W2V) { local = u - CVT_B_W2K; nNt = 2; t.src = p.cmp_k_w2; t.dst = p.w2T; t.ldn = DH; t.K = CMPH; t.nvalid = DH; }
    else if (u < CVT_B_UP) { local = u - CVT_B_W2V; nNt = 2; t.src = p.cmp_v_w2; t.dst = p.w2T + (size_t)256 * CMPH; t.ldn = DH; t.K = CMPH; t.nvalid = DH; }
    else if (u < CVT_B_DN) { const int l2 = u - CVT_B_UP, e = l2 / CVT_T_UP; local = l2 % CVT_T_UP; nNt = 32; mode = 1;
        t.src = p.w_up + (size_t)e * D * 2 * F; t.dst = (bf16_t*)(p.wupq + (size_t)e * 2 * F * D); t.ldn = 2 * F; t.K = D; t.nvalid = 2 * F; }
    else { const int l2 = u - CVT_B_DN, e = l2 / CVT_T_DN; local = l2 % CVT_T_DN; nNt = 16;
        t.src = p.w_down + (size_t)e * F * D; t.dst = (bf16_t*)(p.wdnq + (size_t)e * D * F); t.ldn = D; t.K = F; t.nvalid = D; }
    int nt = local % nNt; const int kt = local / nNt;
    if (u < CVT_B_OUT) nt = nth_set_bit(CVT_IN_BF_TILES, nt); else if (u >= CVT_B_INQ) nt = nth_set_bit(CVT_IN_F8_TILES, nt);
    t.k0 = kt * (u < CVT_B_UP ? 128 : 256); t.n0 = nt * 128;
    if (mode == 1) { const int n = t.n0; t.drow0 = n < F ? (n >> 7) * 256 : ((n - F) >> 7) * 256 + 128; }
    else t.drow0 = t.n0;
    return t;
}
__device__ __forceinline__ void cvt_load(const CvtTile& t, f32x4 (&v)[8]) {
    const int tid = threadIdx.x, ng = tid & 31, kg = tid >> 5;
    const int n = t.n0 + ng * 4;
    const float* s = t.src + (size_t)(t.k0 + kg * 8) * t.ldn + n;
    const bool ok = n < t.nvalid;
#pragma unroll
    for (int i = 0; i < 8; ++i) v[i] = ok ? __builtin_nontemporal_load((const f32x4*)(s + (size_t)i * t.ldn)) : (f32x4){0.f, 0.f, 0.f, 0.f};
}
__device__ __forceinline__ void cvt_pack(const f32x4 (&v)[8], char* ldsc, int ng, int kg) {
#pragma unroll
    for (int c = 0; c < 4; ++c) {
        u32x4 w;
        w.x = cvt_pk_bf16(v[0][c], v[1][c]); w.y = cvt_pk_bf16(v[2][c], v[3][c]);
        w.z = cvt_pk_bf16(v[4][c], v[5][c]); w.w = cvt_pk_bf16(v[6][c], v[7][c]);
        *(u32x4*)(ldsc + (ng * 4 + c) * 256 + ((kg ^ (ng & 15)) << 4)) = w;
    }
}
__device__ __forceinline__ void cvt_store(const CvtTile& cur, const char* ldsc, int tid) {
    const int kc = tid & 15;
#pragma unroll
    for (int i = 0; i < 4; ++i) {
        const int nr = (tid >> 4) + 32 * i;
        const u32x4 w = *(const u32x4*)(ldsc + nr * 256 + ((kc ^ ((nr >> 2) & 15)) << 4));
        const int drow = cur.perm ? in_colmap(cur.n0 + nr) : cur.drow0 + nr;
        *(u32x4*)(cur.dst + (size_t)drow * cur.K + cur.k0 + kc * 8) = w;
    }
}
__device__ __forceinline__ void cvt_load8(const CvtTile& t, f32x4 (&v)[16]) {
    const int tid = threadIdx.x, ng = tid & 31, kg = tid >> 5;
    const float* s = t.src + (size_t)(t.k0 + kg * 16) * t.ldn + t.n0 + ng * 4;
    const bool ok = t.n0 + ng * 4 < t.nvalid;
#pragma unroll
    for (int i = 0; i < 16; ++i) v[i] = ok ? __builtin_nontemporal_load((const f32x4*)(s + (size_t)i * t.ldn)) : (f32x4){0.f, 0.f, 0.f, 0.f};
}
__device__ __forceinline__ unsigned pack4_fp8(float a, float b, float c, float d) {
    int w = 0;
    w = __builtin_amdgcn_cvt_pk_fp8_f32(a, b, w, false);
    w = __builtin_amdgcn_cvt_pk_fp8_f32(c, d, w, true);
    return (unsigned)w;
}
__device__ __forceinline__ void cvt_pack8(const f32x4 (&v)[16], char* ldsc, int ng, int kg) {
#pragma unroll
    for (int c = 0; c < 4; ++c) {
        u32x4 w;
        w.x = pack4_fp8(v[0][c] * F8_WMUL, v[1][c] * F8_WMUL, v[2][c] * F8_WMUL, v[3][c] * F8_WMUL);
        w.y = pack4_fp8(v[4][c] * F8_WMUL, v[5][c] * F8_WMUL, v[6][c] * F8_WMUL, v[7][c] * F8_WMUL);
        w.z = pack4_fp8(v[8][c] * F8_WMUL, v[9][c] * F8_WMUL, v[10][c] * F8_WMUL, v[11][c] * F8_WMUL);
        w.w = pack4_fp8(v[12][c] * F8_WMUL, v[13][c] * F8_WMUL, v[14][c] * F8_WMUL, v[15][c] * F8_WMUL);
        *(u32x4*)(ldsc + (ng * 4 + c) * 256 + ((kg ^ (ng & 15)) << 4)) = w;
    }
}
__device__ __forceinline__ void cvt_store8(const CvtTile& cur, const char* ldsc, int tid) {
    const int kc = tid & 15;
    char* dst = (char*)cur.dst;
#pragma unroll
    for (int i = 0; i < 4; ++i) {
        const int nr = (tid >> 4) + 32 * i;
        const int ns = cur.perm ? nr : (nr & ~31) + perm32(nr & 31);
        const u32x4 w = *(const u32x4*)(ldsc + ns * 256 + ((kc ^ ((ns >> 2) & 15)) << 4));
        const int drow = cur.perm ? in_colmap(cur.n0 + nr) : cur.drow0 + nr;
        *(u32x4*)(dst + (size_t)drow * cur.K + cur.k0 + kc * 16) = w;
    }
}
__device__ __forceinline__ void ph_convert(const P& p, char* ldsc) {
    const int tid = threadIdx.x, ng = tid & 31, kg = tid >> 5, G_ = gridDim.x;
    {
        int u = blockIdx.x;
        if (u < CVT_B_UP) {
            CvtTile tA = cvt_decode(p, u), tB = tA;
            f32x4 vA[8], vB[8];
            cvt_load(tA, vA);
            bool hasB = u + G_ < CVT_B_UP;
            if (hasB) { tB = cvt_decode(p, u + G_); cvt_load(tB, vB); }
            int buf = 0;
            for (;;) {
                cvt_pack(vA, ldsc + buf * 32768, ng, kg);
                const CvtTile curA = tA;
                const bool hasA2 = u + 2 * G_ < CVT_B_UP;
                if (hasA2) { tA = cvt_decode(p, u + 2 * G_); cvt_load(tA, vA); }
                __syncthreads();
                cvt_store(curA, ldsc + buf * 32768, tid);
                buf ^= 1;
                if (!hasB) break;
                cvt_pack(vB, ldsc + buf * 32768, ng, kg);
                const CvtTile curB = tB;
                const bool hasB2 = u + 3 * G_ < CVT_B_UP;
                if (hasB2) { tB = cvt_decode(p, u + 3 * G_); cvt_load(tB, vB); }
                __syncthreads();
                cvt_store(curB, ldsc + buf * 32768, tid);
                buf ^= 1;
                if (!hasA2) break;
                hasB = hasB2;
                u += 2 * G_;
            }
        }
        __syncthreads();
    }
    {
        int* slot = (int*)(ldsc + 65536);
        int tick = 0;
        if (tid == 0) { slot[0] = atomicAdd(p.queue + 48, 1); slot[1] = atomicAdd(p.queue + 48, 1); tick = atomicAdd(p.queue + 48, 1); }
        __syncthreads();
        int uA = CVT_B_UP + __builtin_amdgcn_readfirstlane(slot[0]), uB = CVT_B_UP + __builtin_amdgcn_readfirstlane(slot[1]);
        if (uA < CVT_TOTAL) {
            CvtTile tA = cvt_decode(p, uA), tB = tA;
            f32x4 vA[16], vB[16];
            cvt_load8(tA, vA);
            bool hasB = uB < CVT_TOTAL;
            if (hasB) { tB = cvt_decode(p, uB); cvt_load8(tB, vB); }
            int buf = 0;
            for (;;) {
                cvt_pack8(vA, ldsc + buf * 32768, ng, kg);
                const CvtTile curA = tA;
                if (tid == 0) { slot[2] = tick; tick = atomicAdd(p.queue + 48, 1); }
                __syncthreads();
                uA = CVT_B_UP + __builtin_amdgcn_readfirstlane(slot[2]);
                const bool hasA2 = uA < CVT_TOTAL;
                if (hasA2) { tA = cvt_decode(p, uA); cvt_load8(tA, vA); }
                cvt_store8(curA, ldsc + buf * 32768, tid);
                buf ^= 1;
                if (!hasB) break;
                cvt_pack8(vB, ldsc + buf * 32768, ng, kg);
                const CvtTile curB = tB;
                if (tid == 0) { slot[3] = tick; tick = atomicAdd(p.queue + 48, 1); }
                __syncthreads();
                uB = CVT_B_UP + __builtin_amdgcn_readfirstlane(slot[3]);
                const bool hasB2 = uB < CVT_TOTAL;
                if (hasB2) { tB = cvt_decode(p, uB); cvt_load8(tB, vB); }
                cvt_store8(curB, ldsc + buf * 32768, tid);
                buf ^= 1;
                if (!hasA2) break;
                hasB = hasB2;
            }
        }
        __syncthreads();
    }
}

constexpr int G_BK = 64, G_HALF = 128, G_HTB = G_HALF * G_BK * 2  , GEMM_LDS = 8 * G_HTB;
__device__ __forceinline__ int lds_byte(int r, int c) { const int st = (r >> 4) * 2 + (c >> 5), rr = r & 15, cc = c & 31, ob = rr * 64 + cc * 2; return st * 1024 + (ob ^ (((ob >> 9) & 1) << 5)); }
__device__ __forceinline__ void stage_rc(int b, int& R, int& C) { const int st = b / 1024, sb = b % 1024, swz = sb ^ (((sb >> 9) & 1) << 5); R = (st >> 1) * 16 + swz / 64; C = (st & 1) * 32 + (swz % 64) / 2; }

struct GNoInit { __device__ __forceinline__ void operator()(f32x4 (&)[2][2][4][2], int, int, int, int) const {} };
template <bool F8, class RowOff, class KOff, class Epi, class Init = GNoInit>
__device__ __forceinline__ void gemm256(const bf16_t* A, RowOff rowoff, KOff koff, const bf16_t* Bt, int ldb, int K, char* shm, Epi epi, Init init = Init()) {
#define G_SA(b, h) (shm + ((b) * 2 + (h)) * G_HTB)
#define G_SB(b, h) (shm + (4 + (b) * 2 + (h)) * G_HTB)
#define G_STAGE_A(T_, P_, h_, kt_) do { const int _so = 2 * (int)koff(kt_); _Pragma("unroll") for (int _i = 0; _i < 2; ++_i) { const int _b = (T_) * 16 + _i * 8192; int _r, _c; stage_rc(_b, _r, _c); \
        __builtin_amdgcn_raw_ptr_buffer_load_lds(rsrcA, (__attribute__((address_space(3))) void*)((P_) + _b), 16, 2 * (int)(rowoff((h_) * G_HALF + _r) + _c), _so, 0, 0); } } while (0)
#define G_STAGE_B(T_, P_, h_, kt_) do { const int _so = 2 * ((h_) * G_HALF * ldb + (kt_) * G_BK); _Pragma("unroll") for (int _i = 0; _i < 2; ++_i) { const int _b = (T_) * 16 + _i * 8192; int _r, _c; stage_rc(_b, _r, _c); \
        __builtin_amdgcn_raw_ptr_buffer_load_lds(rsrcB, (__attribute__((address_space(3))) void*)((P_) + _b), 16, 2 * (_r * ldb + _c), _so, 0, 0); } } while (0)
#define G_LDA(dst, b, h) do { if (F8) { _Pragma("unroll") for (int m = 0; m < 4; ++m) { \
            const i32x4 lo_ = *reinterpret_cast<const i32x4*>(G_SA(b, h) + lds_byte(wr * 64 + m * 16 + fr, fq * 8)), hi_ = *reinterpret_cast<const i32x4*>(G_SA(b, h) + lds_byte(wr * 64 + m * 16 + fr, 32 + fq * 8)); \
            dst##8[m] = __builtin_shufflevector(lo_, hi_, 0, 1, 2, 3, 4, 5, 6, 7); } } \
        else { _Pragma("unroll") for (int m = 0; m < 4; ++m) _Pragma("unroll") for (int k = 0; k < 2; ++k) \
            dst[m][k] = *reinterpret_cast<const bf16x8*>(G_SA(b, h) + lds_byte(wr * 64 + m * 16 + fr, k * 32 + fq * 8)); } } while (0)
#define G_LDB(dst, b, h) do { if (F8) { _Pragma("unroll") for (int n = 0; n < 2; ++n) { \
            const i32x4 lo_ = *reinterpret_cast<const i32x4*>(G_SB(b, h) + lds_byte(wc * 32 + n * 16 + fr, fq * 8)), hi_ = *reinterpret_cast<const i32x4*>(G_SB(b, h) + lds_byte(wc * 32 + n * 16 + fr, 32 + fq * 8)); \
            dst##8[n] = __builtin_shufflevector(lo_, hi_, 0, 1, 2, 3, 4, 5, 6, 7); } } \
        else { _Pragma("unroll") for (int n = 0; n < 2; ++n) _Pragma("unroll") for (int k = 0; k < 2; ++k) \
            dst[n][k] = *reinterpret_cast<const bf16x8*>(G_SB(b, h) + lds_byte(wc * 32 + n * 16 + fr, k * 32 + fq * 8)); } } while (0)
#define G_MMA(ai, bj, At_, Bt_) do { __builtin_amdgcn_s_setprio(1); \
        if (F8) { _Pragma("unroll") for (int m = 0; m < 4; ++m) _Pragma("unroll") for (int n = 0; n < 2; ++n) \
                asm volatile("v_mfma_scale_f32_16x16x128_f8f6f4 %0, %1, %2, %0, %3, %4 op_sel_hi:[0,0,0]" : "+v"(acc[ai][bj][m][n]) : "v"(Bt_##8[n]), "v"(At_##8[m]), "v"(f8sw), "v"(f8sa)); } \
        else { _Pragma("unroll") for (int m = 0; m < 4; ++m) _Pragma("unroll") for (int n = 0; n < 2; ++n) _Pragma("unroll") for (int k = 0; k < 2; ++k) \
            acc[ai][bj][m][n] = __builtin_amdgcn_mfma_f32_16x16x32_bf16(Bt_[n][k], At_[m][k], acc[ai][bj][m][n], 0, 0, 0); } \
        __builtin_amdgcn_s_setprio(0); } while (0)
#define G_WAIT_V(n) asm volatile("s_waitcnt vmcnt(" #n ")" ::: "memory")
#define G_WAIT_L(n) asm volatile("s_waitcnt lgkmcnt(" #n ")" ::: "memory")
#define G_BAR __builtin_amdgcn_s_barrier()
#define G_SCHED __builtin_amdgcn_sched_barrier(0)
    int t0 = threadIdx.x; asm volatile("" : "+v"(t0));
    const __amdgpu_buffer_rsrc_t rsrcA = __builtin_amdgcn_make_buffer_rsrc((void*)A, 0, -1, 0x00020000), rsrcB = __builtin_amdgcn_make_buffer_rsrc((void*)Bt, 0, -1, 0x00020000);
    int wid = t0 >> 6, lane = t0 & 63, wr = wid >> 2, wc = wid & 3, fr = lane & 15, fq = lane >> 4;
    f32x4 acc[2][2][4][2] = {};
    init(acc, wr, wc, fr, fq);
    bf16x8 At[4][2], B0[2][2], B1[2][2];
    i32x8 At8[4], B08[2], B18[2];
    const int f8sw = F8_SCALE_W, f8sa = F8_SCALE_A;
    const int nt = K / G_BK;
    G_STAGE_B(t0, G_SB(0, 0), 0, 0); G_STAGE_A(t0, G_SA(0, 0), 0, 0);
    G_STAGE_B(t0, G_SB(0, 1), 1, 0); G_STAGE_A(t0, G_SA(0, 1), 1, 0);
    if (wr == 1) G_BAR;
    G_WAIT_V(4); G_BAR;
    G_STAGE_B(t0, G_SB(1, 0), 0, 1); G_STAGE_A(t0, G_SA(1, 0), 0, 1); G_STAGE_B(t0, G_SB(1, 1), 1, 1);
    G_WAIT_V(6); G_BAR;
    for (int t = 0; t < nt - 2; t += 2) {
        G_LDB(B0, 0, 0); G_SCHED; G_LDA(At, 0, 0); G_STAGE_A(t0, G_SA(1, 1), 1, t + 1);
        G_WAIT_L(8); G_BAR; G_WAIT_L(0); G_MMA(0, 0, At, B0); G_BAR; G_SCHED;
        G_LDB(B1, 0, 1); G_STAGE_B(t0, G_SB(0, 0), 0, t + 2);
        G_BAR; G_WAIT_L(0); G_MMA(0, 1, At, B1); G_BAR;
        G_LDA(At, 0, 1); G_STAGE_A(t0, G_SA(0, 0), 0, t + 2);
        G_BAR; G_WAIT_L(0); G_MMA(1, 0, At, B0); G_BAR; G_SCHED;
        G_STAGE_B(t0, G_SB(0, 1), 1, t + 2);
        G_WAIT_V(6); G_BAR; G_MMA(1, 1, At, B1); G_BAR;
        G_LDB(B0, 1, 0); G_SCHED; G_LDA(At, 1, 0); G_STAGE_A(t0, G_SA(0, 1), 1, t + 2);
        G_WAIT_L(8); G_BAR; G_WAIT_L(0); G_MMA(0, 0, At, B0); G_BAR; G_SCHED;
        G_LDB(B1, 1, 1); G_STAGE_B(t0, G_SB(1, 0), 0, t + 3);
        G_BAR; G_WAIT_L(0); G_MMA(0, 1, At, B1); G_BAR;
        G_LDA(At, 1, 1); G_STAGE_A(t0, G_SA(1, 0), 0, t + 3);
        G_BAR; G_WAIT_L(0); G_MMA(1, 0, At, B0); G_BAR; G_SCHED;
        G_STAGE_B(t0, G_SB(1, 1), 1, t + 3);
        G_WAIT_V(6); G_BAR; G_MMA(1, 1, At, B1); G_BAR;
    }
    int tz = threadIdx.x; asm volatile("" : "+v"(tz)); wid = tz >> 6; lane = tz & 63; wr = wid >> 2; wc = wid & 3; fr = lane & 15; fq = lane >> 4;
    { G_LDB(B0, 0, 0); G_WAIT_V(0); G_LDA(At, 0, 0); G_STAGE_A(tz, G_SA(1, 1), 1, nt - 1);
      G_BAR; G_WAIT_L(0); G_MMA(0, 0, At, B0); G_BAR;
      G_LDB(B1, 0, 1); G_BAR; G_WAIT_L(0); G_MMA(0, 1, At, B1); G_BAR;
      G_LDA(At, 0, 1); G_WAIT_V(4); G_BAR; G_WAIT_L(0); G_MMA(1, 0, At, B0); G_MMA(1, 1, At, B1); G_BAR; }
    { G_LDB(B0, 1, 0); G_LDA(At, 1, 0); G_WAIT_V(2); G_BAR; G_WAIT_L(0); G_MMA(0, 0, At, B0); G_BAR;
      G_LDB(B1, 1, 1); G_WAIT_V(0); G_BAR; G_WAIT_L(0); G_MMA(0, 1, At, B1); G_BAR;
      G_LDA(At, 1, 1); G_BAR; G_WAIT_L(0); G_MMA(1, 0, At, B0); G_MMA(1, 1, At, B1); G_BAR; }
    if (wr == 0) G_BAR;
    if (F8) asm volatile("s_nop 7\n\ts_nop 7\n\ts_nop 7" ::: "memory");
    epi(acc, wr, wc, fr, fq);
#undef G_SA
#undef G_SB
#undef G_STAGE_A
#undef G_STAGE_B
#undef G_LDA
#undef G_LDB
#undef G_MMA
#undef G_WAIT_V
#undef G_WAIT_L
#undef G_BAR
#undef G_SCHED
}

template <class Fn>
__device__ __forceinline__ void for_units(int nMt, int nNt, Fn fn) {
    const int nMg = (nMt + 3) >> 2, nNg = (nNt + 7) >> 3, ngroups = nMg * nNg;
    const int xcd = blockIdx.x & 7, local = blockIdx.x >> 3, nlocal = gridDim.x >> 3;
    for (int g = xcd; g < ngroups; g += 8) {
        const int mg = g / nNg, ng = g % nNg;
        for (int l = local; l < 32; l += nlocal) {
            const int mt = mg * 4 + (l & 3), nt = ng * 8 + (l >> 2);
            if (mt < nMt && nt < nNt) fn(mt, nt);
        }
    }
}

constexpr int LDS_RED_OFF = 131072 + 128;
__device__ __forceinline__ const float* head_norm_w(const P& p, int cb) {
    return cb < 8 ? p.nsa_q_norm : (cb == 12 || cb == 13) ? p.nsa_k_norm + DH : (cb == 16 || cb == 17) ? p.nsa_k_norm + 2 * DH : (cb >= 20 && cb < 28) ? p.fox_q_norm : (cb >= 28 && cb < 36) ? p.fox_k_norm : nullptr;
}
template <bool F8>
__device__ __forceinline__ void inproj_unit(const P& p, char* shm, int mt, int nt) {
    bf16_t* C = p.projb;
    float* red = (float*)(shm + LDS_RED_OFF);
    {
        const bf16_t* At = (const bf16_t*)(p.hq + (size_t)mt * 256 * D);
        const float* gw0 = head_norm_w(p, nt * 2), * gw1 = head_norm_w(p, nt * 2 + 1);
        auto epi = [=](const f32x4 (&acc)[2][2][4][2], int wr, int wc, int fr, int fq) {
                    if (gw0 || gw1) {
#pragma unroll
                        for (int ai = 0; ai < 2; ++ai)
#pragma unroll
                            for (int m = 0; m < 4; ++m)
#pragma unroll
                                for (int bj = 0; bj < 2; ++bj) {
                                    const f32x4 a = acc[ai][bj][m][0], b = acc[ai][bj][m][1];
                                    float ss = (a[0] * a[0] + a[1] * a[1]) + (a[2] * a[2] + a[3] * a[3]) + (b[0] * b[0] + b[1] * b[1]) + (b[2] * b[2] + b[3] * b[3]);
                                    { auto r_ = __builtin_amdgcn_permlane16_swap(__float_as_uint(ss), __float_as_uint(ss), false, false); ss = __uint_as_float(r_[0]) + __uint_as_float(r_[1]); }
                                    { auto r_ = __builtin_amdgcn_permlane32_swap(__float_as_uint(ss), __float_as_uint(ss), false, false); ss = __uint_as_float(r_[0]) + __uint_as_float(r_[1]); }
                                    if (fq == 0) red[((ai * 128 + wr * 64 + m * 16 + fr) * 2 + bj) * 4 + wc] = ss;
                                }
                        __syncthreads();
                    }
#pragma unroll
                    for (int ai = 0; ai < 2; ++ai)
#pragma unroll
                        for (int m = 0; m < 4; ++m) {
                            const int rl = ai * 128 + wr * 64 + m * 16 + fr, t = mt * 256 + rl;
                            bf16_t* rowp = C + (size_t)t * IN_PAD + nt * 256 + wc * 32 + fq * 4;
#pragma unroll
                            for (int bj = 0; bj < 2; ++bj) {
                                const int cb = nt * 2 + bj;
                                if (cb == 45) continue;
                                if (cb == 44) {
                                    if (wc == 0) {
#pragma unroll
                                        for (int n = 0; n < 2; ++n)
#pragma unroll
                                            for (int jx = 0; jx < 4; ++jx) {
                                                const int c = n * 16 + fq * 4 + jx; const float v = acc[ai][bj][m][n][jx];
                                                if (c < 24) p.gatesf[(size_t)t * 24 + c] = 1.f / (1.f + __expf(-(v + p.b_nsa_gate[c])));
                                                else p.logf[(size_t)t * 8 + (c - 24)] = log_sigmoid(v + p.fox_forget_bias[c - 24]);
                                            }
                                    }
                                    continue;
                                }
                                const float* gw = bj ? gw1 : gw0;
                                float rs = 1.f;
                                if (gw) { const f32x4 pr = *(const f32x4*)(red + (rl * 2 + bj) * 4); rs = rsqrtf(((pr[0] + pr[1]) + (pr[2] + pr[3])) / DH + EPS); }
#pragma unroll
                                for (int n = 0; n < 2; ++n) {
                                    f32x4 v = acc[ai][bj][m][n] * rs;
                                    if (gw) v = v * *(const f32x4*)(gw + wc * 32 + n * 16 + fq * 4);
                                    u32x2 w; w.x = cvt_pk_bf16(v[0], v[1]); w.y = cvt_pk_bf16(v[2], v[3]);
                                    *(u32x2*)(rowp + bj * 128 + n * 16) = w;
                                }
                            }
                        }
                };
        if (F8) gemm256<true>(At, [](int r) { return r * (D / 2); }, [](int kt) { return kt * G_BK; }, (const bf16_t*)(p.winq + (size_t)nt * 256 * D), D / 2, D / 2, shm, epi);
        else gemm256<false>(p.hb + (size_t)mt * 256 * D, [](int r) { return r * D; }, [](int kt) { return kt * G_BK; }, p.winT + (size_t)nt * 256 * D, D, D, shm, epi);
    }
}
__device__ __forceinline__ void ph_inproj_fast(const P& p, char* shm) {
    const int xcd = blockIdx.x & 7, local = blockIdx.x >> 3, nlocal = gridDim.x >> 3;
    for (int mg = xcd; mg < T / 1024; mg += 8) {
        for (int l = local; l < 32; l += nlocal) {
            const int j = l >> 2, nt = j < 3 ? 5 + 2 * j : j < 7 ? 15 + j : 22;
            inproj_unit<false>(p, shm, mg * 4 + (l & 3), nt);
        }
        for (int l = local; l < 60; l += nlocal) {
            const int k = l >> 2, nt = k < 5 ? k : k == 5 ? 6 : k == 6 ? 8 : k + 3;
            inproj_unit<true>(p, shm, mg * 4 + (l & 3), nt);
        }
    }
}

__device__ __forceinline__ void ph_outproj_fast(const P& p, char* shm) {
    const bf16_t* A = p.mixb; bf16_t* C = p.x1; const float* X = p.x; const float* mod = p.mod;
    for_units(T / 256, D / 256, [&](int mt, int nt) {
        const bf16_t* At = A + (size_t)mt * 256 * D;
        const float* ga = mod + (size_t)((mt * 256) / S) * 6 * D + 2 * D;
        gemm256<false>(At, [](int r) { return r * D; }, [](int kt) { return kt * G_BK; }, p.woutT + (size_t)nt * 256 * D, D, D, shm,
                [=](const f32x4 (&acc)[2][2][4][2], int wr, int wc, int fr, int fq) {
#pragma unroll
                    for (int ai = 0; ai < 2; ++ai)
#pragma unroll
                        for (int m = 0; m < 4; ++m) {
                            const size_t ro = (size_t)(mt * 256 + ai * 128 + wr * 64 + m * 16 + fr) * D;
#pragma unroll
                            for (int bj = 0; bj < 2; ++bj)
#pragma unroll
                                for (int n = 0; n < 2; ++n) {
                                    const int col = nt * 256 + bj * 128 + wc * 32 + n * 16 + fq * 4;
                                    const f32x4 xv = *(const f32x4*)(X + ro + col), gv = *(const f32x4*)(ga + col);
                                    const f32x4 r = xv + gv * acc[ai][bj][m][n];
                                    u32x2 w; w.x = cvt_pk_bf16(r[0], r[1]); w.y = cvt_pk_bf16(r[2], r[3]);
                                    *(u32x2*)(C + ro + col) = w;
                                }
                        }
                });
    });
}

constexpr int CAP = T;
__device__ __forceinline__ void ph_router_fast(const P& p, char* ldsc) {
    unsigned char* h2t = (unsigned char*)ldsc;
    float* rs_l = (float*)(ldsc + 65536);
    char* hsb = ldsc + 65792;
    float* part = (float*)hsb;
    float* logit = (float*)(hsb + 32768);
    int* destl = (int*)(hsb + 32768 + 32 * 33 * 4);
    int* hist = destl + 128;
    int tid = threadIdx.x; asm volatile("" : "+v"(tid));
    const int w = tid >> 6, lane = tid & 63;
    for (int blk = blockIdx.x; blk < T / 32; blk += gridDim.x) {
        const int t0 = blk * 32, b = t0 / S;
        __syncthreads();
#pragma unroll
        for (int q = 0; q < 4; ++q) {
            const bf16_t* xr = p.x1 + (size_t)(t0 + w * 4 + q) * D;
            float ss = 0.f;
#pragma unroll
            for (int i = 0; i < 8; ++i) { const f32x4 v = bf16x4_f(*(const u32x2*)(xr + (i * 64 + lane) * 4)); ss += v[0] * v[0] + v[1] * v[1] + v[2] * v[2] + v[3] * v[3]; }
            ss = wave_sum(ss);
            if (lane == 0) rs_l[w * 4 + q] = rsqrtf(ss / D + EPS);
        }
        __syncthreads();
        {
            const int i = lane & 31, hlf = lane >> 5;
            float* hs = (float*)hsb + w * (64 * 36);
            const int lr = lane >> 3, lc = (lane & 7) * 4;
            const float* rw = p.router_w + (size_t)(w * 256 + hlf * 128) * NE + i;
            f32x16 acc = {};
            f32x4 xv[8];
#define R_LOAD(ch_) do { _Pragma("unroll") for (int jj = 0; jj < 8; ++jj) { const int row = lr + 8 * jj; \
                xv[jj] = bf16x4_f(*(const u32x2*)(p.x1 + (size_t)(t0 + (row & 31)) * D + w * 256 + (row >> 5) * 128 + (ch_) * 32 + lc)); } } while (0)
            R_LOAD(0);
#pragma unroll 1
            for (int ch = 0; ch < 4; ++ch) {
#pragma unroll
                for (int jj = 0; jj < 8; ++jj) {
                    const int row = lr + 8 * jj, tok = row & 31, kk = w * 256 + (row >> 5) * 128 + ch * 32 + lc;
                    const float rsi = rs_l[tok];
                    const f32x4 gv = *(const f32x4*)(p.norm_moe + kk), sv = *(const f32x4*)(p.mod + (size_t)b * 6 * D + 4 * D + kk), hv = *(const f32x4*)(p.mod + (size_t)b * 6 * D + 3 * D + kk);
                    f32x4 h;
#pragma unroll
                    for (int c = 0; c < 4; ++c) h[c] = xv[jj][c] * rsi * gv[c] * (1.f + sv[c]) + hv[c];
                    *(unsigned*)(h2t + tok * D + kk) = pack4_fp8(h[0], h[1], h[2], h[3]);
                    *(f32x4*)(hs + row * 36 + lc) = h;
                }
                if (ch < 3) R_LOAD(ch + 1);
#pragma unroll
                for (int q = 0; q < 8; ++q) {
                    const f32x4 h = *(const f32x4*)(hs + (hlf * 32 + i) * 36 + q * 4);
#pragma unroll
                    for (int c = 0; c < 4; ++c) acc = __builtin_amdgcn_mfma_f32_32x32x2f32(h[c], rw[(size_t)(ch * 32 + q * 4 + c) * NE], acc, 0, 0, 0);
                }
            }
#undef R_LOAD
            __syncthreads();
            const int hi = lane >> 5;
#pragma unroll
            for (int r = 0; r < 16; ++r) part[(w * 32 + ((r & 3) + 8 * (r >> 2) + 4 * hi)) * 32 + i] = acc[r];
        }
        __syncthreads();
#pragma unroll
        for (int j = 0; j < 2; ++j) {
            const int e2 = tid + j * 512, tok = e2 >> 5, e = e2 & 31;
            float s = p.router_b[e];
#pragma unroll
            for (int ww = 0; ww < 8; ++ww) s += part[(ww * 32 + tok) * 32 + e];
            logit[tok * 33 + e] = s;
        }
        __syncthreads();
        if (tid < 32) {
            float lv[32];
#pragma unroll
            for (int e = 0; e < 32; ++e) lv[e] = logit[tid * 33 + e];
            int ti[4]; float tv[4];
#pragma unroll
            for (int k = 0; k < 4; ++k) {
                float bv = lv[0]; int bi = 0;
#pragma unroll
                for (int e = 1; e < 32; ++e) if (lv[e] > bv) { bv = lv[e]; bi = e; }
                ti[k] = bi; tv[k] = bv;
#pragma unroll
                for (int e = 0; e < 32; ++e) lv[e] = (e == bi) ? -3.4e38f : lv[e];
            }
            float ex[4], den = 0.f;
#pragma unroll
            for (int k = 0; k < 4; ++k) { ex[k] = __expf(tv[k] - tv[0]); den += ex[k]; }
            const float inv = 1.f / den;
            int lrank[4];
            hist[tid] = 0;
#pragma unroll
            for (int k = 0; k < 4; ++k) lrank[k] = atomicAdd(&hist[ti[k]], 1);
            const int mine = hist[tid];
            hist[32 + tid] = mine > 0 ? atomicAdd(p.cnt + tid * 64, mine) : 0;
#pragma unroll
            for (int k = 0; k < 4; ++k) {
                const int d = ti[k] * CAP + hist[32 + ti[k]] + lrank[k];
                destl[tid * 4 + k] = d;
                p.row_a[d] = (t0 + tid) * 4 + k; p.row_w[d] = ex[k] * inv;
            }
        }
        __syncthreads();
#pragma unroll 4
        for (int a = w; a < 128; a += 8) {
            const unsigned char* src = h2t + (a >> 2) * D;
            unsigned char* dst = p.xgq + (size_t)destl[a] * D;
#pragma unroll
            for (int jj = 0; jj < 2; ++jj) *(u32x4*)(dst + (jj * 64 + lane) * 16) = *(const u32x4*)(src + (jj * 64 + lane) * 16);
        }
    }
}

constexpr int MAXTILES = 160;
constexpr int LDS_TILE_TAB = 131072 + 64;
__device__ __forceinline__ int build_tile_table(const P& p, char* shm) {
    int* tab = (int*)(shm + LDS_TILE_TAB);
    int* cs = (int*)(shm + LDS_TILE_TAB + 1024);
    int tid = threadIdx.x; asm volatile("" : "+v"(tid));
    __syncthreads();
    int nt = 0;
    if (tid < NE) { nt = (p.cnt[tid * 64] + 255) >> 8; cs[tid] = nt; }
    __syncthreads();
    if (tid < NE) {
        int base = 0;
#pragma unroll
        for (int e = 0; e < NE; ++e) base += e < tid ? cs[e] : 0;
        for (int jt = 0; jt < nt; ++jt) tab[1 + base + jt] = (tid << 8) | jt;
        if (tid == NE - 1) tab[0] = base + nt;
    }
    __syncthreads();
    return __builtin_amdgcn_readfirstlane(tab[0]);
}

__device__ __forceinline__ void ph_up_fast(const P& p, char* shm) {
    const int ntiles = build_tile_table(p, shm);
    const int* tab = (const int*)(shm + LDS_TILE_TAB) + 1;
    for_units(ntiles, 16, [&](int mt, int nt) {
        const int te = __builtin_amdgcn_readfirstlane(tab[mt]), e = te >> 8;
        const size_t row0 = (size_t)e * CAP + (size_t)(te & 255) * 256;
        const bf16_t* At = (const bf16_t*)(p.xgq + row0 * D);
        const float* bu = p.b_up + (size_t)e * 2 * F + nt * 128;
        unsigned char* C = p.actq + row0 * F + nt * 128;
        gemm256<true>(At, [](int r) { return r * (D / 2); }, [](int kt) { return kt * G_BK; }, (const bf16_t*)(p.wupq + ((size_t)e * 2 * F + (size_t)nt * 256) * D), D / 2, D / 2, shm,
                [=](const f32x4 (&acc)[2][2][4][2], int wr, int wc, int fr, int fq) {
                    const int col = wc * 32 + fq * 8;
#pragma unroll
                    for (int ai = 0; ai < 2; ++ai)
#pragma unroll
                        for (int m = 0; m < 4; ++m) {
                            float o[8];
#pragma unroll
                            for (int n = 0; n < 2; ++n) {
                                const f32x4 g4 = acc[ai][0][m][n], l4 = acc[ai][1][m][n];
#pragma unroll
                                for (int j = 0; j < 4; j += 2) {
                                    const f32x2 gl = {__builtin_amdgcn_fmed3f(g4[j], -3.0e38f, 7.f), __builtin_amdgcn_fmed3f(g4[j + 1], -3.0e38f, 7.f)};
                                    const f32x2 li = {__builtin_amdgcn_fmed3f(l4[j], -7.f, 7.f), __builtin_amdgcn_fmed3f(l4[j + 1], -7.f, 7.f)};
                                    const f32x2 t = gl * (-1.702f * 1.4426950408889634f);
                                    const f32x2 d = (f32x2){__builtin_amdgcn_exp2f(t[0]), __builtin_amdgcn_exp2f(t[1])} + 1.f;
                                    const f32x2 r = {__builtin_amdgcn_rcpf(d[0]), __builtin_amdgcn_rcpf(d[1])};
                                    const f32x2 ov = (gl * r) * (li + 1.f);
                                    o[n * 4 + j] = ov[0]; o[n * 4 + j + 1] = ov[1];
                                }
                            }
                            u32x2 wv; wv.x = pack4_fp8(o[0], o[1], o[2], o[3]); wv.y = pack4_fp8(o[4], o[5], o[6], o[7]);
                            *(u32x2*)(C + (size_t)(ai * 128 + wr * 64 + m * 16 + fr) * F + col) = wv;
                        }
                },
                [=](f32x4 (&acc)[2][2][4][2], int, int wc, int, int fq) {
                    const int col = wc * 32 + fq * 8;
#pragma unroll
                    for (int n = 0; n < 2; ++n) {
                        const f32x4 bg = *(const f32x4*)(bu + col + 4 * n), bl = *(const f32x4*)(bu + F + col + 4 * n);
#pragma unroll
                        for (int ai = 0; ai < 2; ++ai)
#pragma unroll
                            for (int m = 0; m < 4; ++m) { acc[ai][0][m][n] = bg; acc[ai][1][m][n] = bl; }
                    }
                });
    });
}

__device__ __forceinline__ void ph_down_fast(const P& p, char* shm) {
    const int ntiles = __builtin_amdgcn_readfirstlane(*(const int*)(shm + LDS_TILE_TAB));
    const int* tab = (const int*)(shm + LDS_TILE_TAB) + 1;
    for_units(ntiles, 8, [&](int mt, int nt) {
        const int te = __builtin_amdgcn_readfirstlane(tab[mt]), e = te >> 8;
        const size_t row0 = (size_t)e * CAP + (size_t)(te & 255) * 256;
        const int nvalid = p.cnt[e * 64] - (te & 255) * 256;
        const bf16_t* At = (const bf16_t*)(p.actq + row0 * F);
        const float* bd = p.b_down + (size_t)e * D + nt * 256;
        const int* ra = p.row_a + row0; const float* rwt = p.row_w + row0;
        unsigned char* Y = p.yq + nt * 256;
        int rav[2][4]; float rwv[2][4];
        gemm256<true>(At, [](int r) { return r * (F / 2); }, [](int kt) { return kt * G_BK; }, (const bf16_t*)(p.wdnq + ((size_t)e * D + (size_t)nt * 256) * F), F / 2, F / 2, shm,
                [=, &rav, &rwv](const f32x4 (&acc)[2][2][4][2], int wr, int wc, int fr, int fq) {
#pragma unroll
                    for (int ai = 0; ai < 2; ++ai)
#pragma unroll
                        for (int m = 0; m < 4; ++m) {
                            const int row = ai * 128 + wr * 64 + m * 16 + fr;
                            if (row < nvalid) {
                                const int a = rav[ai][m];
                                const float wgt = rwv[ai][m];
                                unsigned char* yr = Y + (size_t)a * D;
#pragma unroll
                                for (int bj = 0; bj < 2; ++bj) {
                                    const int col = bj * 128 + wc * 32 + fq * 8;
                                    f32x4 s0 = acc[ai][bj][m][0] * wgt, s1 = acc[ai][bj][m][1] * wgt;
#pragma unroll
                                    for (int j = 0; j < 4; ++j) { s0[j] = __builtin_amdgcn_fmed3f(s0[j], -448.f, 448.f); s1[j] = __builtin_amdgcn_fmed3f(s1[j], -448.f, 448.f); }
                                    u32x2 wv; wv.x = pack4_fp8(s0[0], s0[1], s0[2], s0[3]); wv.y = pack4_fp8(s1[0], s1[1], s1[2], s1[3]);
                                    *(u32x2*)(yr + col) = wv;
                                }
                            }
                        }
                },
                [=, &rav, &rwv](f32x4 (&acc)[2][2][4][2], int wr, int wc, int fr, int fq) {
#pragma unroll
                    for (int ai = 0; ai < 2; ++ai)
#pragma unroll
                        for (int m = 0; m < 4; ++m) { const int row = ai * 128 + wr * 64 + m * 16 + fr; rav[ai][m] = ra[row]; rwv[ai][m] = rwt[row] * 16.f; }
#pragma unroll
                    for (int bj = 0; bj < 2; ++bj)
#pragma unroll
                        for (int n = 0; n < 2; ++n) {
                            const f32x4 b = *(const f32x4*)(bd + bj * 128 + wc * 32 + fq * 8 + 4 * n);
#pragma unroll
                            for (int ai = 0; ai < 2; ++ai)
#pragma unroll
                                for (int m = 0; m < 4; ++m) acc[ai][bj][m][n] = b;
                        }
                });
    });
}

__device__ __forceinline__ void ph_final_fast(const P& p) {
    constexpr size_t NV = (size_t)T * D / 4;
    const size_t stride = (size_t)gridDim.x * NTHR;
    int tid = threadIdx.x; asm volatile("" : "+v"(tid));
    for (size_t i0 = (size_t)blockIdx.x * NTHR + tid; i0 < NV; i0 += 4 * stride) {
        unsigned yv[4][4]; f32x4 xv[4], gm[4];
#pragma unroll
        for (int u = 0; u < 4; ++u) {
            size_t i = i0 + u * stride; i = i < NV ? i : NV - 1;
            const size_t t = i / (D / 4); const int n = (int)(i % (D / 4)) * 4;
#pragma unroll
            for (int k = 0; k < 4; ++k) yv[u][k] = *(const unsigned*)(p.yq + (t * 4 + k) * D + n);
            xv[u] = bf16x4_f(*(const u32x2*)(p.x1 + t * D + n));
            gm[u] = *(const f32x4*)(p.mod + (t / S) * 6 * D + 5 * D + n);
        }
#pragma unroll
        for (int u = 0; u < 4; ++u) {
            const size_t i = i0 + u * stride;
            f32x4 s = {0.f, 0.f, 0.f, 0.f};
#pragma unroll
            for (int k = 0; k < 4; ++k) { const f32x2 lo = __builtin_amdgcn_cvt_pk_f32_fp8((int)yv[u][k], false), hi = __builtin_amdgcn_cvt_pk_f32_fp8((int)yv[u][k], true); s[0] += lo[0]; s[1] += lo[1]; s[2] += hi[0]; s[3] += hi[1]; }
            if (i < NV) *(f32x4*)(p.out + i * 4) = xv[u] + gm[u] * s * 0.0625f;
        }
    }
}

typedef short s16x4 __attribute__((ext_vector_type(4)));
constexpr int A_SHM = 64 * 128 * 2;
constexpr int A_OFF_V = 0, A_OFF_K = 2 * A_SHM, A_OFF_WS = 4 * A_SHM, A_OFF_TBL = A_OFF_WS + 8 * 64 * 4, A_OFF_CK = A_OFF_TBL + 8 * 128 * 4, A_OFF_Q = A_OFF_CK + 2 * 64 * 4, A_OFF_SEL = A_OFF_Q + 256, A_OFF_CUM = A_OFF_SEL + 256;
constexpr float LOG2E = 1.4426950408889634f;
#define A_KSWZ(row, colB) ((row) * 256 + ((colB) ^ (((row) & 7) << 4)))
__device__ __forceinline__ int a_v_st(int k, int c) { const int kk = (k & ~0xC) | ((k & 4) << 1) | ((k & 8) >> 1); return ((kk >> 3) * 4 + (c >> 5)) * 512 + ((kk & 7) * 32 + (c & 31)) * 2; }
__device__ __forceinline__ int a_v_rd_base(int lane) { return ((lane & 3) << 3) | (((lane >> 2) & 3) << 6) | (((lane >> 4) & 1) << 5) | (((lane >> 5) & 1) << 8); }
__device__ __forceinline__ int a_crow(int r, int hi) { return (r & 3) + 8 * (r >> 2) + 4 * hi; }

__device__ __forceinline__ void a_qkt(f32x16& p0, f32x16& p1, const char* kbase, int r32, int hi, const bf16x8* qr) {
    p0 = f32x16{}; p1 = f32x16{};
    const char* kb[4];
#pragma unroll
    for (int dd = 0; dd < 4; ++dd) kb[dd] = kbase + A_KSWZ(r32, (dd * 16 + hi * 8) * 2);
#pragma unroll
    for (int d0 = 0; d0 < 8; ++d0) {
        const char* a = kb[d0 & 3] + (d0 >> 2) * 128;
        const bf16x8 b0 = *reinterpret_cast<const bf16x8*>(a);
        const bf16x8 b1 = *reinterpret_cast<const bf16x8*>(a + 32 * 256);
        p0 = __builtin_amdgcn_mfma_f32_32x32x16_bf16(b0, qr[d0], p0, 0, 0, 0);
        p1 = __builtin_amdgcn_mfma_f32_32x32x16_bf16(b1, qr[d0], p1, 0, 0, 0);
    }
}
__device__ __forceinline__ void a_pv(f32x16* o, int vb, bf16x8 pa0, bf16x8 pa1, bf16x8 pa2, bf16x8 pa3) {
#define A_TRRD(dst, off) asm volatile("ds_read_b64_tr_b16 %0, %1 offset:%2" : "=&v"(dst) : "v"(vb), "i"(off) : "memory")
#define A_RD8(S_, d0) do { constexpr int b_ = (d0) * 512; \
        A_TRRD(S_##l0, b_); A_TRRD(S_##h0, b_ + 2048); A_TRRD(S_##l1, b_ + 4096); A_TRRD(S_##h1, b_ + 6144); A_TRRD(S_##l2, b_ + 8192); A_TRRD(S_##h2, b_ + 10240); A_TRRD(S_##l3, b_ + 12288); A_TRRD(S_##h3, b_ + 14336); } while (0)
#define A_MM4(S_, d0) do { \
        o[d0] = __builtin_amdgcn_mfma_f32_32x32x16_bf16(pa0, (bf16x8){S_##l0[0], S_##l0[1], S_##l0[2], S_##l0[3], S_##h0[0], S_##h0[1], S_##h0[2], S_##h0[3]}, o[d0], 0, 0, 0); \
        o[d0] = __builtin_amdgcn_mfma_f32_32x32x16_bf16(pa1, (bf16x8){S_##l1[0], S_##l1[1], S_##l1[2], S_##l1[3], S_##h1[0], S_##h1[1], S_##h1[2], S_##h1[3]}, o[d0], 0, 0, 0); \
        o[d0] = __builtin_amdgcn_mfma_f32_32x32x16_bf16(pa2, (bf16x8){S_##l2[0], S_##l2[1], S_##l2[2], S_##l2[3], S_##h2[0], S_##h2[1], S_##h2[2], S_##h2[3]}, o[d0], 0, 0, 0); \
        o[d0] = __builtin_amdgcn_mfma_f32_32x32x16_bf16(pa3, (bf16x8){S_##l3[0], S_##l3[1], S_##l3[2], S_##l3[3], S_##h3[0], S_##h3[1], S_##h3[2], S_##h3[3]}, o[d0], 0, 0, 0); } while (0)
    s16x4 xl0, xl1, xl2, xl3, xh0, xh1, xh2, xh3, yl0, yl1, yl2, yl3, yh0, yh1, yh2, yh3;
    A_RD8(x, 0);
    A_RD8(y, 1);
    asm volatile("s_waitcnt lgkmcnt(8)" ::: "memory"); __builtin_amdgcn_sched_barrier(0);
    A_MM4(x, 0);
    __builtin_amdgcn_sched_barrier(0);
    A_RD8(x, 2);
    asm volatile("s_waitcnt lgkmcnt(8)" ::: "memory"); __builtin_amdgcn_sched_barrier(0);
    A_MM4(y, 1);
    __builtin_amdgcn_sched_barrier(0);
    A_RD8(y, 3);
    asm volatile("s_waitcnt lgkmcnt(8)" ::: "memory"); __builtin_amdgcn_sched_barrier(0);
    A_MM4(x, 2);
    asm volatile("s_waitcnt lgkmcnt(0)" ::: "memory"); __builtin_amdgcn_sched_barrier(0);
    A_MM4(y, 3);
#undef A_MM4
#undef A_RD8
#undef A_TRRD
}

__device__ __forceinline__ void a_build_tbl(const P& p, char* lds) {
    float* tbl = (float*)(lds + A_OFF_TBL);
    for (int i = threadIdx.x; i < 8 * 128; i += NTHR) { const int h = i >> 7, d = i & 127; tbl[i] = p.rel_bias[BUCKET[d] * 8 + h] * LOG2E; }
}

template <int MODE>
__device__ __forceinline__ void attn_unit(const P& p, int b, int hh, int qb, char* lds) {
    int tid = threadIdx.x; asm volatile("" : "+v"(tid));
    const int wid = __builtin_amdgcn_readfirstlane(tid >> 6), lane = tid & 63, r32 = lane & 31, hi = lane >> 5;
    int h, q0, qlo, qoff, koff, voff, j_lo, j_hi;
    if (MODE == 2) { h = hh; q0 = qb * 256; qlo = q0 + 32 * wid; qoff = OFF_QF + h * DH; koff = OFF_KF + h * DH; voff = OFF_VF + h * DH; j_lo = 0; j_hi = 4 * qb + 4; }
    else { h = hh * R + (wid >> 1); q0 = qb * 64; qlo = q0 + 32 * (wid & 1); qoff = OFF_QN + h * DH;
           koff = (MODE == 0 ? OFF_KW : OFF_KS) + hh * DH; voff = (MODE == 0 ? OFF_VW : OFF_VS) + hh * DH;
           j_lo = (MODE == 0 && q0 > 511) ? ((q0 - 511) >> 6) : 0; j_hi = qb + 1; }
    const int NT = j_hi - j_lo;
    const bf16_t* base = p.projb + (size_t)b * S * IN_PAD;
    char* V_lds = lds + A_OFF_V; char* K_lds = lds + A_OFF_K;
    float* ws = (float*)(lds + A_OFF_WS) + wid * 64; float* li_l = ws; float* al_l = ws + 32;
    const float* tbl = (const float*)(lds + A_OFF_TBL) + h * 128;
    float* cum_l = (float*)(lds + A_OFF_CUM);
    bf16x8 qr[8];
    {
        const bf16_t* qrow = base + (size_t)(qlo + r32) * IN_PAD + qoff + hi * 8;
#pragma unroll
        for (int d0 = 0; d0 < 8; ++d0) qr[d0] = *reinterpret_cast<const bf16x8*>(qrow + d0 * 16);
    }
    unsigned selm = 0xffffffffu;
    const float c31 = (MODE == 2) ? 0.f : tbl[127];
    constexpr float C2 = LOG2E * SCALE;
    constexpr float THR2 = 8.f * LOG2E;
    constexpr unsigned WMASK = MODE == 0 ? 512u : 0x80000000u;
    const int sr = tid >> 4, sc = (tid & 15) * 8;
    const int kws = A_KSWZ(sr, sc * 2), vst0 = a_v_st(sr, sc), vst1 = a_v_st(32 + sr, sc);
    const int vb0 = (int)(uintptr_t)V_lds + a_v_rd_base(lane);
    float m_reg = -1e30f, l_reg = 0.f; f32x16 o[4] = {};
    bf16x8 st_k0, st_k1, st_v0, st_v1;
#define A_LOAD(kb_) do { const bf16_t* r0_ = base + (size_t)((kb_) + sr) * IN_PAD + sc; const bf16_t* r1_ = r0_ + (size_t)32 * IN_PAD; \
        st_k0 = *reinterpret_cast<const bf16x8*>(r0_ + koff); st_k1 = *reinterpret_cast<const bf16x8*>(r1_ + koff); \
        st_v0 = *reinterpret_cast<const bf16x8*>(r0_ + voff); st_v1 = *reinterpret_cast<const bf16x8*>(r1_ + voff); \
        } while (0)
#define A_WRITE(bf_) do { *(bf16x8*)(K_lds + (bf_) * A_SHM + kws) = st_k0; *(bf16x8*)(K_lds + (bf_) * A_SHM + kws + 32 * 256) = st_k1; \
        *(bf16x8*)(V_lds + (bf_) * A_SHM + vst0) = st_v0; *(bf16x8*)(V_lds + (bf_) * A_SHM + vst1) = st_v1; \
        } while (0)
    __syncthreads();
    A_LOAD(j_lo * 64);
    float v4[4] = {0.f, 0.f, 0.f, 0.f};
    if (MODE == 2) {
        const int nkeys = q0 + 256;
        const float* lf = p.logf + (size_t)b * S * 8 + h;
#pragma unroll
        for (int i = 0; i < 4; ++i) { const int sidx = tid * 4 + i; v4[i] = sidx < nkeys ? lf[(size_t)sidx * 8] : 0.f; }
    }
    A_WRITE(0);
    if (MODE == 2) {
        float run = 0.f;
#pragma unroll
        for (int i = 0; i < 4; ++i) { run += v4[i]; v4[i] = run; }
        float inc = run;
#pragma unroll
        for (int o = 1; o < 64; o <<= 1) { const float nb = __shfl_up(inc, o); if (lane >= o) inc += nb; }
        float* wtot = ws + 48;
        float* wsum = (float*)(lds + A_OFF_Q) + 16;
        (void)wtot;
        if (lane == 63) wsum[wid] = inc;
        __syncthreads();
        float basew = 0.f;
#pragma unroll
        for (int i = 0; i < 8; ++i) basew += i < wid ? wsum[i] : 0.f;
        const float excl = basew + inc - run;
#pragma unroll
        for (int i = 0; i < 4; ++i) cum_l[tid * 4 + i] = -(excl + v4[i]) * LOG2E;
    }
    __syncthreads();
    if (MODE == 1) selm = ((const unsigned*)(lds + A_OFF_SEL))[qlo - q0 + r32];
    for (int t = 0; t < NT; ++t) {
        const int bf = t & 1, kb = (j_lo + t) * 64;
        if (t + 1 < NT) A_LOAD(kb + 64);
        const bool act = kb <= qlo + 31 && (MODE != 0 || kb + 63 >= qlo - 511);
        if (act) {
            f32x16 p0, p1;
            a_qkt(p0, p1, K_lds + bf * A_SHM, r32, hi, qr);
            const int dq = qlo + r32 - kb - 4 * hi;
            if (MODE == 2) {
                const float* ck = cum_l + kb + 4 * hi;
#pragma unroll
                for (int i = 0; i < 4; ++i) {
                    const f32x4 c0 = *(const f32x4*)(ck + 8 * i), c1 = *(const f32x4*)(ck + 32 + 8 * i);
#pragma unroll
                    for (int j = 0; j < 4; ++j) { p0[4 * i + j] = fmaf(p0[4 * i + j], C2, c0[j]); p1[4 * i + j] = fmaf(p1[4 * i + j], C2, c1[j]); }
                }
            } else {
                const bool far = qlo - (kb + 63) >= 113;
                if (far) {
                    const float cf = (MODE == 1 && !((selm >> (j_lo + t)) & 1u)) ? -__builtin_inff() : c31;
#pragma unroll
                    for (int r = 0; r < 16; ++r) { p0[r] = fmaf(p0[r], C2, cf); p1[r] = fmaf(p1[r], C2, cf); }
                } else {
#pragma unroll
                    for (int r = 0; r < 16; ++r) {
                        const int c = (r & 3) + 8 * (r >> 2);
                        const int d0i = min(max(dq - c, 0), 127), d1i = min(max(dq - c - 32, 0), 127);
                        p0[r] = fmaf(p0[r], C2, tbl[d0i]); p1[r] = fmaf(p1[r], C2, tbl[d1i]);
                    }
                }
            }
            const bool needmask = (kb + 63 > qlo) || (MODE == 0 && (qlo + 31 - kb) >= 512);
            if (needmask) {
                const float NEG = -__builtin_inff();
#pragma unroll
                for (int r = 0; r < 16; ++r) {
                    const int c = (r & 3) + 8 * (r >> 2);
                    if ((unsigned)(dq - c) >= WMASK) p0[r] = NEG;
                    if ((unsigned)(dq - c - 32) >= WMASK) p1[r] = NEG;
                }
            }
            if (MODE == 1 && !(qlo - (kb + 63) >= 113)) {
                if (!((selm >> (j_lo + t)) & 1u)) {
                    const float NEG = -__builtin_inff();
#pragma unroll
                    for (int r = 0; r < 16; ++r) { p0[r] = NEG; p1[r] = NEG; }
                }
            }
            float pmax = p0[0];
#pragma unroll
            for (int r = 1; r < 16; ++r) pmax = fmaxf(pmax, p0[r]);
#pragma unroll
            for (int r = 0; r < 16; ++r) pmax = fmaxf(pmax, p1[r]);
            { auto rr = __builtin_amdgcn_permlane32_swap(__float_as_uint(pmax), __float_as_uint(pmax), false, false);
              pmax = fmaxf(__uint_as_float(rr[0]), __uint_as_float(rr[1])); }
            float mn, alpha;
            if (__all(pmax - m_reg <= THR2)) { mn = m_reg; alpha = 1.f; }
            else { mn = fmaxf(m_reg, pmax); alpha = __builtin_amdgcn_exp2f(m_reg - mn); m_reg = mn; }
#pragma unroll
            for (int r = 0; r < 16; ++r) { p0[r] = __builtin_amdgcn_exp2f(p0[r] - mn); p1[r] = __builtin_amdgcn_exp2f(p1[r] - mn); }
            float ps = 0.f;
#pragma unroll
            for (int r = 0; r < 16; ++r) ps += p0[r];
#pragma unroll
            for (int r = 0; r < 16; ++r) ps += p1[r];
            { auto rr = __builtin_amdgcn_permlane32_swap(__float_as_uint(ps), __float_as_uint(ps), false, false);
              ps = __uint_as_float(rr[0]) + __uint_as_float(rr[1]); }
            l_reg = l_reg * alpha + ps;
            bf16x8 pa0, pa1, pa2, pa3;
#define A_PK4(P_, B_, OUT) do { unsigned a0 = cvt_pk_bf16(P_[B_ + 0], P_[B_ + 1]), a1 = cvt_pk_bf16(P_[B_ + 2], P_[B_ + 3]); \
        unsigned b0 = cvt_pk_bf16(P_[B_ + 4], P_[B_ + 5]), b1 = cvt_pk_bf16(P_[B_ + 6], P_[B_ + 7]); \
        auto r0 = __builtin_amdgcn_permlane32_swap(a0, b0, false, false); auto r1 = __builtin_amdgcn_permlane32_swap(a1, b1, false, false); \
        u32x4 w_ = {r0[0], r1[0], r0[1], r1[1]}; OUT = *reinterpret_cast<bf16x8*>(&w_); } while (0)
            A_PK4(p0, 0, pa0); A_PK4(p0, 8, pa1); A_PK4(p1, 0, pa2); A_PK4(p1, 8, pa3);
#undef A_PK4
            if (__any(alpha < 1.f)) {
                if (hi == 0) al_l[r32] = alpha;
                asm volatile("s_waitcnt lgkmcnt(0)" ::: "memory");
#pragma unroll
                for (int r = 0; r < 16; ++r) { const float a = al_l[a_crow(r, hi)];
#pragma unroll
                    for (int d_ = 0; d_ < 4; ++d_) o[d_][r] *= a; }
            }
            a_pv(o, vb0 + bf * A_SHM, pa0, pa1, pa2, pa3);
        }
        if (t + 1 < NT) A_WRITE(bf ^ 1);
        __syncthreads();
    }
#undef A_LOAD
#undef A_WRITE
    if (hi == 0) li_l[r32] = l_reg;
    asm volatile("s_waitcnt lgkmcnt(0)" ::: "memory");
    bf16_t* obuf = (MODE == 0 ? p.owinb : MODE == 1 ? p.oslcb : p.ofoxb) + (size_t)(b * S + qlo) * 1024 + h * DH;
#pragma unroll
    for (int r = 0; r < 16; ++r) {
        const int orow = a_crow(r, hi);
        const float rl = __builtin_amdgcn_rcpf(li_l[orow]);
#pragma unroll
        for (int d0 = 0; d0 < 4; ++d0) {
            const float v = o[d0][r] * rl;
            const float vn = __int_as_float(__builtin_amdgcn_update_dpp(0, __float_as_int(v), 0xB1, 0xf, 0xf, false));
            if ((r32 & 1) == 0) *(unsigned*)(obuf + (size_t)orow * 1024 + d0 * 32 + r32) = cvt_pk_bf16(v, vn);
        }
    }
}

__device__ __forceinline__ int next_unit(int* ctr, char* lds) {
    int* slot = (int*)(lds + A_OFF_Q);
    __syncthreads();
    if (threadIdx.x == 0) *slot = atomicAdd(ctr, 1);
    __syncthreads();
    return __builtin_amdgcn_readfirstlane(*slot);
}
constexpr int A_OFF_SLAB = 81920;
__device__ __forceinline__ void cmpattn_unit(const P& p, int b, int g, int qb, char* lds) {
    int tid = threadIdx.x; asm volatile("" : "+v"(tid));
    const int wid = __builtin_amdgcn_readfirstlane(tid >> 6), lane = tid & 63, r32 = lane & 31, hi = lane >> 5;
    const int hl = wid >> 1, h = g * R + hl, q0 = qb * 64, qlo = q0 + 32 * (wid & 1), tq = qlo + r32;
    const int nk = min(NCMP, 4 * qb + 3), NT = (nk + 63) >> 6;
    char* V_lds = lds + A_OFF_V; char* K_lds = lds + A_OFF_K;
    float* ws = (float*)(lds + A_OFF_WS) + wid * 64; float* li_l = ws;
    const float* tbl = (const float*)(lds + A_OFF_TBL) + h * 128;
    float* slab = (float*)(lds + A_OFF_SLAB);
    bf16x8 qr[8];
    {
        const bf16_t* qrow = p.projb + (size_t)(b * S + tq) * IN_PAD + OFF_QN + h * DH + hi * 8;
#pragma unroll
        for (int d0 = 0; d0 < 8; ++d0) qr[d0] = *reinterpret_cast<const bf16x8*>(qrow + d0 * 16);
    }
    const int sr = tid >> 4, sc = (tid & 15) * 8;
    const int kws = A_KSWZ(sr, sc * 2), vst0 = a_v_st(sr, sc), vst1 = a_v_st(32 + sr, sc);
    __syncthreads();
    {
        f32x4* z = (f32x4*)slab;
#pragma unroll
        for (int i = 0; i < 4; ++i) z[tid + i * NTHR] = (f32x4){0.f, 0.f, 0.f, 0.f};
        bf16x8 sk0[2], sk1[2], sv0[2], sv1[2];
#pragma unroll
        for (int t = 0; t < 2; ++t) {
            const int n0 = min(t * 64 + sr, NCMP - 1), n1 = min(t * 64 + 32 + sr, NCMP - 1);
            const bf16_t* k0p = p.cmpb + ((size_t)((b * NCMP + n0) * G + g)) * DH + sc;
            const bf16_t* k1p = p.cmpb + ((size_t)((b * NCMP + n1) * G + g)) * DH + sc;
            sk0[t] = *reinterpret_cast<const bf16x8*>(k0p); sk1[t] = *reinterpret_cast<const bf16x8*>(k1p);
            sv0[t] = *reinterpret_cast<const bf16x8*>(k0p + (size_t)1024 * DH); sv1[t] = *reinterpret_cast<const bf16x8*>(k1p + (size_t)1024 * DH);
        }
#pragma unroll
        for (int t = 0; t < 2; ++t) {
            if (t < NT) {
                *(bf16x8*)(K_lds + t * A_SHM + kws) = sk0[t]; *(bf16x8*)(K_lds + t * A_SHM + kws + 32 * 256) = sk1[t];
                *(bf16x8*)(V_lds + t * A_SHM + vst0) = sv0[t]; *(bf16x8*)(V_lds + t * A_SHM + vst1) = sv1[t];
            }
        }
    }
    __syncthreads();
    constexpr float C2 = LOG2E * SCALE;
    const float c31 = tbl[127];
    const float NEG = -__builtin_inff();
    f32x16 pp[4];
#pragma unroll
    for (int t = 0; t < 2; ++t) {
        if (t < NT) {
            a_qkt(pp[2 * t], pp[2 * t + 1], K_lds + t * A_SHM, r32, hi, qr);
#pragma unroll
            for (int a = 0; a < 2; ++a) {
                const int nb = t * 64 + a * 32;
                const int dq = tq - 31 - 16 * (nb + 4 * hi);
                const bool far = (qlo - 31 - 16 * (nb + 31)) >= 113;
                if (far) {
#pragma unroll
                    for (int r = 0; r < 16; ++r) pp[2 * t + a][r] = fmaf(pp[2 * t + a][r], C2, c31);
                } else {
#pragma unroll
                    for (int r = 0; r < 16; ++r) {
                        const int c = (r & 3) + 8 * (r >> 2);
                        const int d = dq - 16 * c;
                        const float x = fmaf(pp[2 * t + a][r], C2, tbl[min(max(d, 0), 127)]);
                        pp[2 * t + a][r] = d < 0 ? NEG : x;
                    }
                }
            }
        } else {
#pragma unroll
            for (int r = 0; r < 16; ++r) { pp[2 * t][r] = NEG; pp[2 * t + 1][r] = NEG; }
        }
    }
    float pmax = NEG;
#pragma unroll
    for (int a = 0; a < 4; ++a)
#pragma unroll
        for (int r = 0; r < 16; ++r) pmax = fmaxf(pmax, pp[a][r]);
    { auto rr = __builtin_amdgcn_permlane32_swap(__float_as_uint(pmax), __float_as_uint(pmax), false, false);
      pmax = fmaxf(__uint_as_float(rr[0]), __uint_as_float(rr[1])); }
    const float mn = fmaxf(pmax, -1e30f);
    float ps = 0.f;
#pragma unroll
    for (int a = 0; a < 4; ++a)
#pragma unroll
        for (int r = 0; r < 16; ++r) { pp[a][r] = __builtin_amdgcn_exp2f(pp[a][r] - mn); ps += pp[a][r]; }
    { auto rr = __builtin_amdgcn_permlane32_swap(__float_as_uint(ps), __float_as_uint(ps), false, false);
      ps = __uint_as_float(rr[0]) + __uint_as_float(rr[1]); }
    const float inv_l = ps > 0.f ? __builtin_amdgcn_rcpf(ps) : 0.f;
    {
        float* sl = slab + (size_t)(hl * 32) * 64 + (32 * (wid & 1) + r32);
#pragma unroll
        for (int a = 0; a < 4; ++a)
#pragma unroll
            for (int i = 0; i < 4; ++i) {
                const int j = 8 * a + 2 * i + hi;
                const float A = ((pp[a][4 * i] + pp[a][4 * i + 1]) + (pp[a][4 * i + 2] + pp[a][4 * i + 3])) * inv_l;
                const float L = pp[a][4 * i + 3] * inv_l;
                atomicAdd(sl + j * 64, A);
                if (j < 31) atomicAdd(sl + (j + 1) * 64, L);
            }
    }
    f32x16 o[4] = {};
    const int vb0 = (int)(uintptr_t)V_lds + a_v_rd_base(lane);
#define C_PK4(P_, B_, OUT) do { unsigned a0 = cvt_pk_bf16(P_[B_ + 0], P_[B_ + 1]), a1 = cvt_pk_bf16(P_[B_ + 2], P_[B_ + 3]); \
        unsigned b0 = cvt_pk_bf16(P_[B_ + 4], P_[B_ + 5]), b1 = cvt_pk_bf16(P_[B_ + 6], P_[B_ + 7]); \
        auto r0 = __builtin_amdgcn_permlane32_swap(a0, b0, false, false); auto r1 = __builtin_amdgcn_permlane32_swap(a1, b1, false, false); \
        u32x4 w_ = {r0[0], r1[0], r0[1], r1[1]}; OUT = *reinterpret_cast<bf16x8*>(&w_); } while (0)
#pragma unroll
    for (int t = 0; t < 2; ++t) {
        if (t < NT) {
            bf16x8 pa0, pa1, pa2, pa3;
            C_PK4(pp[2 * t], 0, pa0); C_PK4(pp[2 * t], 8, pa1); C_PK4(pp[2 * t + 1], 0, pa2); C_PK4(pp[2 * t + 1], 8, pa3);
            a_pv(o, vb0 + t * A_SHM, pa0, pa1, pa2, pa3);
        }
    }
#undef C_PK4
    if (hi == 0) li_l[r32] = inv_l;
    asm volatile("s_waitcnt lgkmcnt(0)" ::: "memory");
    bf16_t* obuf = p.ocmpb + (size_t)(b * S + qlo) * 1024 + h * DH;
#pragma unroll
    for (int r = 0; r < 16; ++r) {
        const int orow = a_crow(r, hi);
        const float rl = li_l[orow];
#pragma unroll
        for (int d0 = 0; d0 < 4; ++d0) {
            const float v = o[d0][r] * rl;
            const float vn = __int_as_float(__builtin_amdgcn_update_dpp(0, __float_as_int(v), 0xB1, 0xf, 0xf, false));
            if ((r32 & 1) == 0) *(unsigned*)(obuf + (size_t)orow * 1024 + d0 * 32 + r32) = cvt_pk_bf16(v, vn);
        }
    }
    __syncthreads();
    float* impS = (float*)K_lds;
    unsigned* selw = (unsigned*)(lds + A_OFF_SEL);
    {
        const int cur = qb;
#pragma unroll
        for (int i = 0; i < 4; ++i) {
            const int j = wid * 4 + i;
            float s = 0.f;
#pragma unroll
            for (int hh = 0; hh < 4; ++hh) s += slab[(hh * 32 + j) * 64 + lane];
            const bool forced = (j == 0) || (j == cur) || (j == cur - 1);
            impS[j * 64 + lane] = forced ? 1e6f : (j <= cur ? s : -1e6f);
        }
        if (wid == 0) selw[lane] = 0u;
    }
    __syncthreads();
    {
        float imp[32];
#pragma unroll
        for (int j = 0; j < 32; ++j) imp[j] = impS[j * 64 + lane];
        unsigned mask = 0;
#pragma unroll
        for (int i = 0; i < 4; ++i) {
            const int j = wid * 4 + i;
            const float mine = impS[j * 64 + lane];
            int rank = 0;
#pragma unroll
            for (int j2 = 0; j2 < 32; ++j2) rank += (imp[j2] > mine || (imp[j2] == mine && j2 < j)) ? 1 : 0;
            mask |= rank < 16 ? (1u << j) : 0u;
        }
        atomicOr(&selw[lane], mask);
    }
}

constexpr int CMP_KS = 8;
__device__ __forceinline__ void cmp1_unit(const P& p, char* shm, int u) {
    {
        const int ks = u % CMP_KS, mt = (u / CMP_KS) & 3, kv = u / (4 * CMP_KS);
        const bf16_t* A = p.projb + (kv ? OFF_VC : OFF_KC);
        float* C = p.hidp + ((size_t)(kv * CMP_KS + ks) * 1024 + mt * 256) * CMPH;
        gemm256<false>(A,
                [=](int r) { int m = mt * 256 + r; m = m < CMPR ? m : CMPR - 1; const int g = m & 1, bn = m >> 1, n = bn % NCMP, b = bn / NCMP; return (b * S + 16 * n) * IN_PAD + g * DH; },
                [=](int kt) { const int ka = ks * (4096 / CMP_KS / G_BK) + kt; return (ka >> 1) * IN_PAD + (ka & 1) * G_BK; },
                p.w1T + (size_t)kv * CMPH * 4096 + ks * (4096 / CMP_KS), 4096, 4096 / CMP_KS, shm,
                [=](const f32x4 (&acc)[2][2][4][2], int wr, int wc, int fr, int fq) {
#pragma unroll
                    for (int ai = 0; ai < 2; ++ai)
#pragma unroll
                        for (int m = 0; m < 4; ++m)
#pragma unroll
                            for (int bj = 0; bj < 2; ++bj)
#pragma unroll
                                for (int n = 0; n < 2; ++n)
                                    *(f32x4*)(C + (size_t)(ai * 128 + wr * 64 + m * 16 + fr) * CMPH + bj * 128 + wc * 32 + n * 16 + fq * 4) = acc[ai][bj][m][n];
                });
    }
}
__device__ __forceinline__ void ph_cmp_bias(const P& p, float* lds) {
    const int tid = threadIdx.x, tx = tid & 15, ty = tid >> 4;
    for (int u = blockIdx.x; u < 8; u += gridDim.x) {
        const int kv = u >> 2, n0 = (u & 3) * 64 + tx * 4;
        const float* pos = kv ? p.cmp_pos_v : p.cmp_pos_k; const float* w1 = kv ? p.cmp_v_w1 : p.cmp_k_w1;
        float a0 = 0.f, a1 = 0.f, a2 = 0.f, a3 = 0.f;
#pragma unroll 4
        for (int k = ty * 128; k < ty * 128 + 128; ++k) {
            const float4 w = *(const float4*)(w1 + (size_t)k * CMPH + n0); const float pv = pos[k];
            a0 += pv * w.x; a1 += pv * w.y; a2 += pv * w.z; a3 += pv * w.w;
        }
        __syncthreads();
        lds[ty * 64 + tx * 4 + 0] = a0; lds[ty * 64 + tx * 4 + 1] = a1; lds[ty * 64 + tx * 4 + 2] = a2; lds[ty * 64 + tx * 4 + 3] = a3;
        __syncthreads();
        if (tid < 64) { float s = 0.f; for (int i = 0; i < 32; ++i) s += lds[i * 64 + tid]; p.bias1[kv * CMPH + (u & 3) * 64 + tid] = s; }
        __syncthreads();
    }
}
__device__ __forceinline__ void cmp2_block_unit(const P& p, float* lds, int j) {
    int tid = threadIdx.x; asm volatile("" : "+v"(tid));
    const int w = tid >> 6, lane = tid & 63;
    float* hs = lds + w * 1024;
    const int kv = j >> 5, r0 = (j & 31) * 32 + w * 4;
    if (r0 < CMPR) {
        const f32x4 b1 = *(const f32x4*)(p.bias1 + kv * CMPH + lane * 4);
#pragma unroll 2
        for (int q = 0; q < 4; ++q) {
            f32x4 s = b1;
#pragma unroll
            for (int ks = 0; ks < CMP_KS; ++ks) s += *(const f32x4*)(p.hidp + ((size_t)(kv * CMP_KS + ks) * 1024 + r0 + q) * CMPH + lane * 4);
            f32x4 g; for (int j = 0; j < 4; ++j) g[j] = gelu_tanh(s[j]);
            *(f32x4*)(hs + q * 256 + lane * 4) = g;
        }
        const float* w2 = kv ? p.cmp_v_w2 : p.cmp_k_w2;
        float o[4][2] = {};
        for (int k0 = 0; k0 < CMPH; k0 += 32) {
            float2 wv[32];
#pragma unroll
            for (int i = 0; i < 32; ++i) wv[i] = *(const float2*)(w2 + (size_t)(k0 + i) * DH + 2 * lane);
#pragma unroll
            for (int i8 = 0; i8 < 32; i8 += 8) {
#pragma unroll
                for (int i = i8; i < i8 + 8; ++i)
#pragma unroll
                    for (int q = 0; q < 4; ++q) { const float hv = hs[q * 256 + k0 + i]; o[q][0] += hv * wv[i].x; o[q][1] += hv * wv[i].y; }
                __builtin_amdgcn_sched_barrier(0);
            }
        }
#pragma unroll
        for (int q = 0; q < 4; ++q) {
            float v0 = o[q][0], v1 = o[q][1];
            if (kv == 0) { const float rs = rsqrtf(wave_sum(v0 * v0 + v1 * v1) / DH + EPS); v0 *= rs * p.nsa_k_norm[2 * lane]; v1 *= rs * p.nsa_k_norm[2 * lane + 1]; }
            *(unsigned*)(p.cmpb + ((size_t)kv * 1024 + r0 + q) * DH + 2 * lane) = pk_bf16(v0, v1);
        }
    }
}

__device__ __forceinline__ void sync_publish(unsigned* ctr) {
    asm volatile("s_waitcnt vmcnt(0)" ::: "memory");
    __syncthreads();
    if (threadIdx.x == 0) {
        __builtin_amdgcn_fence(__ATOMIC_RELEASE, "agent");
        asm volatile("s_waitcnt vmcnt(0)" ::: "memory");
        (void)__hip_atomic_fetch_add(ctr, 1u, __ATOMIC_RELAXED, __HIP_MEMORY_SCOPE_AGENT);
    }
}
__device__ __forceinline__ void sync_wait_ge(unsigned* ctr, unsigned target) {
    if (threadIdx.x == 0) {
        unsigned sp = 0;
        while (__hip_atomic_load(ctr, __ATOMIC_RELAXED, __HIP_MEMORY_SCOPE_AGENT) < target) { __builtin_amdgcn_s_sleep(1); if (++sp > (1u << 22)) break; }
        __builtin_amdgcn_fence(__ATOMIC_ACQUIRE, "agent");
        asm volatile("s_waitcnt vmcnt(0)" ::: "memory");
    }
    __syncthreads();
}
constexpr int SY_CMP1 = 0, SY_CMP2 = 8;
__device__ __forceinline__ void ph_attention(const P& p, char* lds, int qo = 0) {
    unsigned* sy = p.sync;
    if (blockIdx.x < 2 * 4 * CMP_KS) {
        const int u = blockIdx.x;
        cmp1_unit(p, lds, u);
        sync_publish(sy + (SY_CMP1 + (u / CMP_KS)) * 64);
        const int kv2 = u >> 5, mt2 = (u & 31) >> 3;
        sync_wait_ge(sy + (SY_CMP1 + kv2 * 4 + mt2) * 64, CMP_KS);
        cmp2_block_unit(p, (float*)lds, u);
        sync_publish(sy + SY_CMP2 * 64);
        __syncthreads();
    }
    for (;;) {
        const int u = next_unit(p.queue + 0 + qo, lds);
        if (u >= 256) break;
        const int bh = u & 31;
        attn_unit<2>(p, bh >> 3, bh & 7, 7 - (u >> 5), lds);
    }
    a_build_tbl(p, lds);
    sync_wait_ge(sy + SY_CMP2 * 64, 2 * 4 * CMP_KS);
    for (;;) {
        const int u = next_unit(p.queue + 16 + qo, lds);
        if (u >= 256) break;
        const int bg = u & 7, qb = 31 - (u >> 3);
        cmpattn_unit(p, bg >> 1, bg & 1, qb, lds);
        attn_unit<1>(p, bg >> 1, bg & 1, qb, lds);
    }
    for (;;) {
        const int u = next_unit(p.queue + 32 + qo, lds);
        if (u >= 256) break;
        const int bg = u & 7;
        attn_unit<0>(p, bg >> 1, bg & 1, 31 - (u >> 3), lds);
    }
}

constexpr int LDS_BAR_OFF = 139776;
constexpr int LDS_TOTAL = LDS_BAR_OFF + 64;
__global__ void __launch_bounds__(NTHR, 2) k_mega(P p) {
    extern __shared__ __attribute__((aligned(16))) char shm[];
    float* lds = (float*)shm;
    volatile LAS unsigned* xbw = (volatile LAS unsigned*)(shm + LDS_BAR_OFF);
    if (threadIdx.x == 0) { xbw[0] = 0u; xbw[1] = 0u; xbw[2] = 0u; xbw[3] = 0u; }
    __syncthreads();
    XcdBarrier bar = xcd_barrier_post(p.bar, xbw);
    ph_mod(p, lds); __syncthreads(); ph_cmp_bias(p, lds); __syncthreads(); ph_convert(p, shm);   xcd_barrier(bar);
    ph_rms1_b(p, lds);                               xcd_barrier(bar);
    ph_inproj_fast(p, shm);                          xcd_barrier(bar);
    ph_attention(p, shm);                            xcd_barrier(bar);
    ph_combine(p, lds);                              xcd_barrier(bar);
    ph_outproj_fast(p, shm);                         xcd_barrier(bar);
    ph_router_fast(p, shm);                          xcd_barrier(bar);
    ph_up_fast(p, shm);                              xcd_barrier(bar);
    ph_down_fast(p, shm);                            xcd_barrier(bar);
    ph_final_fast(p);
}
}

extern "C" void kernel_launch(void* const* d_in, const int* in_sizes, int n_in, void* d_out, int out_size, void* d_ws, size_t ws_size,
                              hipStream_t stream) {
    (void)in_sizes; (void)n_in; (void)out_size;
    P p{};
    const float* const* in = (const float* const*)d_in;
    p.x = in[0]; p.c = in[1]; p.rel_bias = in[2]; p.mod_w = in[3]; p.mod_b = in[4]; p.norm_attn = in[5]; p.norm_moe = in[6]; p.w_in = in[7];
    p.b_nsa_gate = in[8]; p.nsa_q_norm = in[9]; p.nsa_k_norm = in[10]; p.cmp_pos_k = in[11]; p.cmp_pos_v = in[12]; p.cmp_k_w1 = in[13];
    p.cmp_k_w2 = in[14]; p.cmp_v_w1 = in[15]; p.cmp_v_w2 = in[16]; p.fox_q_norm = in[17]; p.fox_k_norm = in[18]; p.fox_forget_bias = in[19];
    p.out_norm = in[20]; p.w_out = in[21]; p.router_w = in[22]; p.router_b = in[23]; p.w_up = in[24]; p.b_up = in[25]; p.w_down = in[26];
    p.b_down = in[27];
    p.out = (float*)d_out;
    char* ws = (char*)d_ws; size_t off = 0;
    auto take = [&](size_t bytes) { void* r = ws + off; off += (bytes + 255) & ~(size_t)255; return r; };
    p.bar = (unsigned*)take(XCD_BAR_WORDS * sizeof(unsigned));
    p.queue = (int*)take(64 * sizeof(int));
    p.cnt = (int*)take(NE * 64 * sizeof(int));
    p.sync = (unsigned*)take(16 * 64 * sizeof(unsigned));
    const size_t zero_bytes = off;
    p.mod = (float*)take((size_t)NB * 6 * D * 4);
    p.cum = (float*)take((size_t)NB * 8 * S * 4);
    p.x1 = (bf16_t*)take((size_t)T * D * 2);
    p.row_w = (float*)take((size_t)NE * CAP * 4);
    p.row_a = (int*)take((size_t)NE * CAP * 4);
    p.gatesf = (float*)take((size_t)T * 24 * 4);
    p.logf = (float*)take((size_t)T * 8 * 4);
    p.hidp = (float*)take((size_t)2 * CMP_KS * 1024 * CMPH * 4);
    p.bias1 = (float*)take((size_t)2 * CMPH * 4);
    p.winT = (bf16_t*)take((size_t)IN_PAD * D * 2);
    p.woutT = (bf16_t*)take((size_t)D * D * 2);
    p.w1T = (bf16_t*)take((size_t)2 * CMPH * 4096 * 2);
    p.w2T = (bf16_t*)take((size_t)2 * 256 * CMPH * 2);
    p.hb = (bf16_t*)take((size_t)T * D * 2);
    p.projb = (bf16_t*)take((size_t)T * IN_PAD * 2);
    p.mixb = (bf16_t*)take((size_t)T * D * 2);
    p.owinb = (bf16_t*)take((size_t)T * 1024 * 2);
    p.oslcb = (bf16_t*)take((size_t)T * 1024 * 2);
    p.ofoxb = (bf16_t*)take((size_t)T * 1024 * 2);
    p.ocmpb = (bf16_t*)take((size_t)T * 1024 * 2);
    p.cmpb = (bf16_t*)take((size_t)2 * 1024 * DH * 2);
    p.yq = (unsigned char*)take((size_t)TK * D);
    p.wupq = (unsigned char*)take((size_t)NE * 2 * F * D);
    p.wdnq = (unsigned char*)take((size_t)NE * D * F);
    p.xgq = (unsigned char*)take((size_t)NE * CAP * D);
    p.actq = (unsigned char*)take((size_t)NE * CAP * F);
    p.winq = (unsigned char*)take((size_t)IN_PAD * D);
    p.hq = (unsigned char*)take((size_t)T * D);
    if (off > ws_size) { fprintf(stderr, "kernel_launch: workspace too small (%zu > %zu)\n", off, ws_size); return; }

    constexpr size_t kDynLds = LDS_TOTAL;
    constexpr int kBlocksPerCu = 1;
    static int grid = 0;
    if (!grid) {
        int dev = 0, cus = 0, per_cu = 0;
        (void)hipGetDevice(&dev);
        (void)hipDeviceGetAttribute(&cus, hipDeviceAttributeMultiprocessorCount, dev);
        (void)hipFuncSetAttribute((const void*)k_mega, hipFuncAttributeMaxDynamicSharedMemorySize, (int)kDynLds);
        (void)hipOccupancyMaxActiveBlocksPerMultiprocessor(&per_cu, k_mega, NTHR, kDynLds);
        if (cus <= 0) cus = 256;
        if (per_cu < 1) per_cu = 1;
        grid = cus * (per_cu < kBlocksPerCu ? per_cu : kBlocksPerCu);
    }
    (void)hipMemsetAsync(ws, 0, zero_bytes, stream);
    k_mega<<<grid, NTHR, kDynLds, stream>>>(p);
}
```
